# Optimizing an MI355X kernel written in HIP

```python
import jax, jax.numpy as jnp
from jax import lax
import numpy as np


D_MODEL = 1024
BATCH = 8
SEQ = 4096
DEPTH = 2

HEAD_DIM = 64
RET_HEADS = 6
MOBA_HEADS = 6
GMLP_GROUPS = 4
RET_WIDTH = RET_HEADS * HEAD_DIM
MOBA_WIDTH = MOBA_HEADS * HEAD_DIM
GMLP_WIDTH = GMLP_GROUPS * HEAD_DIM
MIX_WIDTH = RET_WIDTH + MOBA_WIDTH + GMLP_WIDTH
IN_WIDTH = 4 * RET_WIDTH + 3 * MOBA_WIDTH + 2 * GMLP_WIDTH
RET_CHUNK = 128
MOBA_BLOCK = 256
MOBA_TOPK = 3
MOBA_QBLOCK = 128
GMLP_CHUNK = 128
D_FF = 3584
N_EXPERTS = 8
TOP_K_EXPERTS = 2
NORM_EPS = 1e-6
GN_EPS = 1e-5

kernel_name = 'hybrid_retention_moba_gmlp_moe'

F32 = jnp.float32


def rmsnorm(x, g):
    xf = x.astype(F32)
    y = xf * lax.rsqrt(jnp.mean(xf * xf, axis=-1, keepdims=True) + NORM_EPS)
    return (y * g.astype(F32)).astype(x.dtype)


def retention(q, k, v):
    B, S, H, D = q.shape
    C = RET_CHUNK
    N = S // C
    dt = q.dtype
    log_g = jnp.log(1.0 - 2.0 ** (-5.0 - jnp.arange(H, dtype=F32)))
    pos = jnp.arange(C, dtype=F32)
    diff = pos[:, None] - pos[None, :]
    decay = jnp.where(diff >= 0, jnp.exp(log_g[:, None, None] * jnp.maximum(diff, 0.0)), 0.0)
    zeta = jnp.exp(log_g[:, None] * (C - 1 - pos))
    xi = jnp.exp(log_g[:, None] * (pos + 1))
    chunk_decay = jnp.exp(log_g * C)

    def to_chunks(t):
        return t.astype(F32).reshape(B, N, C, H, D).transpose(0, 3, 1, 2, 4)

    qc = to_chunks(q)
    kc = to_chunks(k) * (D ** -0.5)
    vc = to_chunks(v)
    scores = jnp.einsum('bhnid,bhnjd->bhnij', qc, kc) * decay[None, :, None]
    intra = jnp.einsum('bhnij,bhnjd->bhnid', scores, vc)
    kv = jnp.einsum('bhncd,bhnce->nbhde', kc * zeta[None, :, None, :, None], vc)

    def step(state, kv_n):
        return state * chunk_decay[None, :, None, None] + kv_n, state

    _, prev = lax.scan(step, jnp.zeros((B, H, D, D), F32), kv)
    cross = jnp.einsum('bhncd,nbhde->bhnce', qc * xi[None, :, None, :, None], prev)
    o = intra + cross
    mu = jnp.mean(o, axis=-1, keepdims=True)
    var = jnp.mean(jnp.square(o - mu), axis=-1, keepdims=True)
    o = (o - mu) * lax.rsqrt(var + GN_EPS)
    return o.transpose(0, 2, 3, 1, 4).reshape(B, S, H * D).astype(dt)


def moba_attention(q, k, v):
    B, S, H, D = q.shape
    BS = MOBA_BLOCK
    QB = MOBA_QBLOCK
    NB = -(-S // BS)
    NQ = S // QB
    TOPK = min(MOBA_TOPK, NB)
    pad = NB * BS - S
    dt = q.dtype
    slopes = 2.0 ** (-8.0 * jnp.arange(1, H + 1, dtype=F32) / H)

    def to_bh(t):
        return t.astype(F32).transpose(0, 2, 1, 3)

    kb = jnp.pad(to_bh(k), ((0, 0), (0, 0), (0, pad), (0, 0))).reshape(B, H, NB, BS, D)
    vb = jnp.pad(to_bh(v), ((0, 0), (0, 0), (0, pad), (0, 0))).reshape(B, H, NB, BS, D)
    kmean = jnp.mean(kb, axis=3)
    q_blocks = (to_bh(q) * (D ** -0.5)).reshape(B, H, NQ, QB, D).transpose(2, 0, 1, 3, 4)
    offs = jnp.arange(BS, dtype=jnp.int32)
    blk_ids = jnp.arange(NB, dtype=jnp.int32)

    def one_block(args):
        q_blk, qi = args
        ob = (qi * QB) // BS
        t = qi * QB + jnp.arange(QB, dtype=jnp.int32)
        bscore = jnp.einsum('bhqd,bhjd->bhqj', q_blk, kmean)
        bscore = jnp.where(blk_ids < ob, bscore, -jnp.inf)
        _, idx = lax.top_k(bscore, TOPK)
        valid = idx < ob
        gidx = idx.reshape(B, H, QB * TOPK)[:, :, :, None, None]
        kg = jnp.take_along_axis(kb, gidx, axis=2).reshape(B, H, QB, TOPK, BS, D)
        vg = jnp.take_along_axis(vb, gidx, axis=2).reshape(B, H, QB, TOPK, BS, D)
        s_pos = idx[..., None] * BS + offs
        dist_sel = (t[:, None, None] - s_pos).astype(F32)
        s_sel = jnp.einsum('bhqd,bhqjsd->bhqjs', q_blk, kg) - slopes[:, None, None, None] * dist_sel
        s_sel = jnp.where(valid[..., None], s_sel, -jnp.inf)
        k_own = lax.dynamic_index_in_dim(kb, ob, axis=2, keepdims=False)
        v_own = lax.dynamic_index_in_dim(vb, ob, axis=2, keepdims=False)
        own_pos = ob * BS + offs
        dist_own = (t[:, None] - own_pos[None, :]).astype(F32)
        s_own = jnp.einsum('bhqd,bhsd->bhqs', q_blk, k_own) - slopes[:, None, None] * dist_own
        s_own = jnp.where(own_pos[None, :] <= t[:, None], s_own, -jnp.inf)
        scores = jnp.concatenate([s_sel.reshape(B, H, QB, TOPK * BS), s_own], axis=-1)
        p = jax.nn.softmax(scores, axis=-1)
        p_sel = p[..., :TOPK * BS].reshape(B, H, QB, TOPK, BS)
        p_own = p[..., TOPK * BS:]
        return (jnp.einsum('bhqjs,bhqjsd->bhqd', p_sel, vg)
                + jnp.einsum('bhqs,bhsd->bhqd', p_own, v_own))

    out = lax.map(one_block, (q_blocks, jnp.arange(NQ, dtype=jnp.int32)))
    return out.transpose(1, 0, 3, 2, 4).reshape(B, S, H * D).astype(dt)


def gmlp_spatial_gate(u, v, w_s, b_s):
    B, S, W = u.shape
    C = GMLP_CHUNK
    N = S // C
    G = GMLP_GROUPS
    Dg = W // G
    u = jax.nn.gelu(u)
    vf = jax.nn.gelu(v).astype(F32)
    mu = jnp.mean(vf, axis=-1, keepdims=True)
    var = jnp.mean(jnp.square(vf - mu), axis=-1, keepdims=True)
    vn = ((vf - mu) * lax.rsqrt(var + GN_EPS)).reshape(B, N, C, G, Dg)
    w = w_s.astype(F32) * jnp.tril(jnp.ones((C, C), F32))[None]
    mixed = jnp.einsum('gij,bnjgd->bnigd', w, vn) + b_s.astype(F32).T[None, None, :, :, None]
    return u * mixed.reshape(B, S, W).astype(u.dtype)


def mixer_block(x, norm_g, w_in, w_out, gmlp_w, gmlp_b):
    B, S, _ = x.shape
    h = rmsnorm(x, norm_g)
    proj = h @ w_in
    cuts = np.cumsum([RET_WIDTH] * 4 + [MOBA_WIDTH] * 3 + [GMLP_WIDTH] * 2)[:-1].tolist()
    rq, rk, rv, rg, mq, mk, mv, gu, gv = jnp.split(proj, cuts, axis=-1)
    heads = lambda t, n: t.reshape(B, S, n, HEAD_DIM)
    ret = retention(heads(rq, RET_HEADS), heads(rk, RET_HEADS), heads(rv, RET_HEADS)) * jax.nn.silu(rg)
    moba = moba_attention(heads(mq, MOBA_HEADS), heads(mk, MOBA_HEADS), heads(mv, MOBA_HEADS))
    gm = gmlp_spatial_gate(gu, gv, gmlp_w, gmlp_b)
    y = jnp.concatenate([ret, moba, gm], axis=-1) @ w_out
    return x + y


def swiglu(h, w_gate, w_up, w_down):
    return (jax.nn.silu(h @ w_gate) * (h @ w_up)) @ w_down


def moe_swiglu(h, router, we_gate, we_up, we_down):
    logits = (h @ router).astype(F32)
    top_val, top_idx = lax.top_k(logits, TOP_K_EXPERTS)
    gates = jax.nn.softmax(top_val, axis=-1)
    dense_gate = jnp.sum(jax.nn.one_hot(top_idx, N_EXPERTS, dtype=F32) * gates[..., None], axis=-2)
    out = jnp.zeros_like(h)
    for e in range(N_EXPERTS):
        out = out + dense_gate[..., e:e + 1].astype(h.dtype) * swiglu(h, we_gate[e], we_up[e], we_down[e])
    return out


def setup_inputs(seed: int = 0) -> dict:
    key = jax.random.key(seed)
    keys = jax.random.split(key, 24)

    def nrm(i, shape, scale):
        return jax.random.normal(keys[i], shape, F32) * scale

    d = D_MODEL ** -0.5
    f = D_FF ** -0.5
    c = 0.5 * GMLP_CHUNK ** -0.5
    return {
        'x': nrm(0, (BATCH, SEQ, D_MODEL), 1.0),
        'l0_mix_norm': 1.0 + nrm(1, (D_MODEL,), 0.05),
        'l0_w_in': nrm(2, (D_MODEL, IN_WIDTH), d),
        'l0_w_out': nrm(3, (MIX_WIDTH, D_MODEL), MIX_WIDTH ** -0.5),
        'l0_gmlp_w': nrm(4, (GMLP_GROUPS, GMLP_CHUNK, GMLP_CHUNK), c),
        'l0_gmlp_b': 1.0 + nrm(5, (GMLP_GROUPS, GMLP_CHUNK), 0.1),
        'l0_ffn_norm': 1.0 + nrm(6, (D_MODEL,), 0.05),
        'l0_w_gate': nrm(7, (D_MODEL, D_FF), d),
        'l0_w_up': nrm(8, (D_MODEL, D_FF), d),
        'l0_w_down': nrm(9, (D_FF, D_MODEL), f),
        'l1_mix_norm': 1.0 + nrm(10, (D_MODEL,), 0.05),
        'l1_w_in': nrm(11, (D_MODEL, IN_WIDTH), d),
        'l1_w_out': nrm(12, (MIX_WIDTH, D_MODEL), MIX_WIDTH ** -0.5),
        'l1_gmlp_w': nrm(13, (GMLP_GROUPS, GMLP_CHUNK, GMLP_CHUNK), c),
        'l1_gmlp_b': 1.0 + nrm(14, (GMLP_GROUPS, GMLP_CHUNK), 0.1),
        'l1_ffn_norm': 1.0 + nrm(15, (D_MODEL,), 0.05),
        'l1_router': nrm(16, (D_MODEL, N_EXPERTS), d),
        'l1_we_gate': nrm(17, (N_EXPERTS, D_MODEL, D_FF), d),
        'l1_we_up': nrm(18, (N_EXPERTS, D_MODEL, D_FF), d),
        'l1_we_down': nrm(19, (N_EXPERTS, D_FF, D_MODEL), f),
        'final_norm': 1.0 + nrm(20, (D_MODEL,), 0.05),
    }


def reference(x, l0_mix_norm, l0_w_in, l0_w_out, l0_gmlp_w, l0_gmlp_b, l0_ffn_norm,
              l0_w_gate, l0_w_up, l0_w_down,
              l1_mix_norm, l1_w_in, l1_w_out, l1_gmlp_w, l1_gmlp_b, l1_ffn_norm,
              l1_router, l1_we_gate, l1_we_up, l1_we_down, final_norm):
    mix_params = [(l0_mix_norm, l0_w_in, l0_w_out, l0_gmlp_w, l0_gmlp_b),
                  (l1_mix_norm, l1_w_in, l1_w_out, l1_gmlp_w, l1_gmlp_b)]
    ffn_norms = [l0_ffn_norm, l1_ffn_norm]
    ffn_params = [(l0_w_gate, l0_w_up, l0_w_down),
                  (l1_router, l1_we_gate, l1_we_up, l1_we_down)]
    for layer in range(DEPTH):
        x = mixer_block(x, *mix_params[layer])
        h = rmsnorm(x, ffn_norms[layer])
        if layer % 2 == 0:
            x = x + swiglu(h, *ffn_params[layer])
        else:
            x = x + moe_swiglu(h, *ffn_params[layer])
    return rmsnorm(x, final_norm)
```

```cpp
#include <hip/hip_runtime.h>
#include <cstdio>
#include <cstdint>
namespace pg8 {
#define PG8_LAS __attribute__((address_space(3)))
typedef unsigned short bf16_t;
typedef short bf16x8 __attribute__((ext_vector_type(8)));
typedef float f32x4 __attribute__((ext_vector_type(4)));
typedef unsigned u32x4 __attribute__((ext_vector_type(4)));
typedef long i64x2 __attribute__((ext_vector_type(2)));
typedef int i32x4 __attribute__((ext_vector_type(4)));
typedef int i32x8 __attribute__((ext_vector_type(8)));
constexpr int BM = 256, BK = 64, HALF = 128, HTB = HALF * BK * 2  , STAGE_BYTES = 8 * HTB, NXCD = 8, WGM = 4;

__host__ __device__ __forceinline__ int lds_byte(int r, int c) { const int st = (r >> 4) * 2 + (c >> 5), rr = r & 15, cc = c & 31, ob = rr * 64 + cc * 2; return st * 1024 + (ob ^ (((ob >> 9) & 1) << 5)); }
__host__ __device__ __forceinline__ void stage_rc(int b, int& R, int& C) { const int st = b / 1024, sb = b % 1024, swz = sb ^ (((sb >> 9) & 1) << 5); R = (st >> 1) * 16 + swz / 64; C = (st & 1) * 32 + (swz % 64) / 2; }
__host__ __device__ __forceinline__ int perm32(int rho) { const int n = rho >> 4, i = rho & 15; return 8 * (i >> 2) + 4 * n + (i & 3); }

struct Unit { int pm, pn, e, kq, sub; };
struct Gemm { const bf16_t* A; const bf16_t* Bt; int K; size_t bstride; const int* rows; int klen; };

struct StaticOrder {
    int nM, nN, nwg, G, c; const int* tile_e;
    int gap_at, gap;
    int nfull, split, part;
    __device__ __forceinline__ void init(int nM_, int nN_, int G_, int c_, const int* te, int split_, int part_) { nM = nM_; nN = nN_; nwg = nM * nN; G = G_; c = c_; tile_e = te;
        split = split_; part = part_; nfull = (split_ > 1) ? (nwg / G_) * G_ : nwg; gap_at = 0x7fffffff; gap = 0; }
    __device__ __forceinline__ void decode(int L, int& pm, int& pn) const {
        int wgid = L; { const int q = nwg / NXCD, r = nwg % NXCD, xcd = wgid % NXCD, off = wgid / NXCD; wgid = (xcd < r ? xcd * (q + 1) : r * (q + 1) + (xcd - r) * q) + off; }
        const int nig = WGM * nN, gid = wgid / nig, fm = gid * WGM, gsz = (nM - fm) < WGM ? (nM - fm) : WGM;
        pm = fm + ((wgid % nig) % gsz); pn = (wgid % nig) / gsz; if (pm >= gap_at) pm += gap; }
    __device__ __forceinline__ bool next(int i, Unit& u, int cofs) const {
        long L = (long)i * G + (c + cofs); u.kq = 0; u.sub = 0;
        if (part == 2) { if (L >= (long)(nwg - nfull) * split) return false; u.sub = (int)L; u.kq = (int)(L % split); L = nfull + L / split; }
        else if (L >= nfull) return false;
        decode((int)L, u.pm, u.pn); u.e = tile_e ? tile_e[u.pm] : 0; return true;
    }
};

__device__ __forceinline__ unsigned cvt_pk_bf16(float lo, float hi) { unsigned r; asm volatile("v_cvt_pk_bf16_f32 %0, %1, %2" : "=v"(r) : "v"(lo), "v"(hi)); return r; }

__device__ __forceinline__ float row_rstd(const unsigned long long* ssq, int row) {
    if (!ssq) return 1.0f;
    const float s = (float)ssq[row] * (1.0f / 16777216.0f);
    return 1.0f / sqrtf(s * (1.0f / 1024.0f) + 1e-6f);
}
struct EpiBf16 {
    static constexpr bool PERM = true;
    bf16_t* O; int ldc; const unsigned long long* ss;
    float scale; int ca0, ca1; float sa; int cb0, cb1; float sb;
    __device__ __forceinline__ void operator()(const f32x4 (&acc)[2][2][4][2], const Unit& u, int wr, int wc, int fr, int fq) const {
        const int row0 = u.pm * BM + wr * 64 + fr, col0 = u.pn * BM + wc * 32 + 8 * fq;
        float rsv[2][4];
#pragma unroll
        for (int ai = 0; ai < 2; ++ai)
#pragma unroll
            for (int m = 0; m < 4; ++m) rsv[ai][m] = row_rstd(ss, row0 + ai * HALF + m * 16) * scale;
        float cs[2];
#pragma unroll
        for (int bj = 0; bj < 2; ++bj) { const int c = u.pn * BM + bj * HALF; cs[bj] = (c >= ca0 && c < ca1) ? sa : (c >= cb0 && c < cb1) ? sb : 1.0f; }
#pragma unroll
        for (int ai = 0; ai < 2; ++ai)
#pragma unroll
            for (int m = 0; m < 4; ++m) { const int row = row0 + ai * HALF + m * 16; bf16_t* rowp = O + (size_t)row * ldc + col0;
#pragma unroll
                for (int bj = 0; bj < 2; ++bj) { const float rs = rsv[ai][m] * cs[bj]; const f32x4 v0 = acc[ai][bj][m][0] * rs, v1 = acc[ai][bj][m][1] * rs;
                    u32x4 w; w.x = cvt_pk_bf16(v0[0], v0[1]); w.y = cvt_pk_bf16(v0[2], v0[3]); w.z = cvt_pk_bf16(v1[0], v1[1]); w.w = cvt_pk_bf16(v1[2], v1[3]);
                    *(u32x4*)(rowp + bj * HALF) = w; } }
    }
};
__device__ __forceinline__ float swiglu_f(float g, float u, float k, float c) { return (g * u) * __builtin_amdgcn_rcpf(fmaf(__builtin_amdgcn_exp2f(g * k), c, c)); }
struct EpiSwiGLU {
    static constexpr bool PERM = true;
    bf16_t* Hd; int ldc; const unsigned long long* ss; float scale;
    __device__ __forceinline__ void operator()(const f32x4 (&acc)[2][2][4][2], const Unit& u, int wr, int wc, int fr, int fq) const {
        const int row0 = u.pm * BM + wr * 64 + fr, col0 = u.pn * HALF + wc * 32 + 8 * fq;
        float rsv[2][4];
#pragma unroll
        for (int ai = 0; ai < 2; ++ai)
#pragma unroll
            for (int m = 0; m < 4; ++m) rsv[ai][m] = row_rstd(ss, row0 + ai * HALF + m * 16) * scale;
#pragma unroll
        for (int ai = 0; ai < 2; ++ai)
#pragma unroll
            for (int m = 0; m < 4; ++m) { const int row = row0 + ai * HALF + m * 16; bf16_t* rowp = Hd + (size_t)row * ldc + col0; const float rs = rsv[ai][m], k = -1.4426950408889634f * rs, c = __builtin_amdgcn_rcpf(rs * rs);
                const f32x4 g0 = acc[ai][0][m][0], g1 = acc[ai][0][m][1], u0 = acc[ai][1][m][0], u1 = acc[ai][1][m][1];
                float h[8];
#pragma unroll
                for (int j = 0; j < 4; ++j) { h[j] = swiglu_f(g0[j], u0[j], k, c); h[4 + j] = swiglu_f(g1[j], u1[j], k, c); }
                u32x4 w; w.x = cvt_pk_bf16(h[0], h[1]); w.y = cvt_pk_bf16(h[2], h[3]); w.z = cvt_pk_bf16(h[4], h[5]); w.w = cvt_pk_bf16(h[6], h[7]);
                *(u32x4*)rowp = w; }
    }
};
__device__ __forceinline__ unsigned pk4_e4m3(float a, float b, float c, float d) {
    a = __builtin_amdgcn_fmed3f(a, -448.f, 448.f); b = __builtin_amdgcn_fmed3f(b, -448.f, 448.f); c = __builtin_amdgcn_fmed3f(c, -448.f, 448.f); d = __builtin_amdgcn_fmed3f(d, -448.f, 448.f);
    unsigned w = 0; w = __builtin_amdgcn_cvt_pk_fp8_f32(a, b, w, false); w = __builtin_amdgcn_cvt_pk_fp8_f32(c, d, w, true); return w; }
__device__ __forceinline__ unsigned pk4_i8(float a, float b, float c, float d) {
    a = __builtin_rintf(__builtin_amdgcn_fmed3f(a, -127.f, 127.f)) + 128.f; b = __builtin_rintf(__builtin_amdgcn_fmed3f(b, -127.f, 127.f)) + 128.f;
    c = __builtin_rintf(__builtin_amdgcn_fmed3f(c, -127.f, 127.f)) + 128.f; d = __builtin_rintf(__builtin_amdgcn_fmed3f(d, -127.f, 127.f)) + 128.f;
    unsigned w = 0; w = __builtin_amdgcn_cvt_pk_u8_f32(a, 0, w); w = __builtin_amdgcn_cvt_pk_u8_f32(b, 1, w); w = __builtin_amdgcn_cvt_pk_u8_f32(c, 2, w); w = __builtin_amdgcn_cvt_pk_u8_f32(d, 3, w);
    return w ^ 0x80808080u; }
struct EpiSwiGLU8 {
    static constexpr bool PERM = true;
    unsigned char* Hd; int ldc; float scale, oscale;
    __device__ __forceinline__ void operator()(const f32x4 (&acc)[2][2][4][2], const Unit& u, int wr, int wc, int fr, int fq) const {
        const int row0 = u.pm * BM + wr * 64 + fr, col0 = u.pn * HALF + wc * 32 + 8 * fq;
        const float k = -1.4426950408889634f * scale, c = 1.0f / (scale * scale * oscale);
#pragma unroll
        for (int ai = 0; ai < 2; ++ai)
#pragma unroll
            for (int m = 0; m < 4; ++m) { const int row = row0 + ai * HALF + m * 16; unsigned char* rowp = Hd + (size_t)row * ldc + col0;
                const f32x4 g0 = acc[ai][0][m][0], g1 = acc[ai][0][m][1], u0 = acc[ai][1][m][0], u1 = acc[ai][1][m][1];
                float h[8];
#pragma unroll
                for (int j = 0; j < 4; ++j) { h[j] = swiglu_f(g0[j], u0[j], k, c); h[4 + j] = swiglu_f(g1[j], u1[j], k, c); }
                typedef unsigned u32x2v __attribute__((ext_vector_type(2))); u32x2v w; w.x = pk4_e4m3(h[0], h[1], h[2], h[3]); w.y = pk4_e4m3(h[4], h[5], h[6], h[7]);
                *(u32x2v*)rowp = w; }
    }
};
__device__ __forceinline__ f32x4 ld4_bf16(const bf16_t* p) { typedef unsigned u32x2v __attribute__((ext_vector_type(2))); const u32x2v w = *(const u32x2v*)p;
    return (f32x4){__builtin_bit_cast(float, w.x << 16), __builtin_bit_cast(float, w.x & 0xffff0000u), __builtin_bit_cast(float, w.y << 16), __builtin_bit_cast(float, w.y & 0xffff0000u)}; }
__device__ __forceinline__ f32x4 st4_bf16(bf16_t* p, const f32x4 v) { typedef unsigned u32x2v __attribute__((ext_vector_type(2))); u32x2v w; w.x = cvt_pk_bf16(v[0], v[1]); w.y = cvt_pk_bf16(v[2], v[3]); *(u32x2v*)p = w;
    return (f32x4){__builtin_bit_cast(float, w.x << 16), __builtin_bit_cast(float, w.x & 0xffff0000u), __builtin_bit_cast(float, w.y << 16), __builtin_bit_cast(float, w.y & 0xffff0000u)}; }
struct EpiResF32 {
    static constexpr bool PERM = false;
    const void* base; bf16_t* out; int ldb, ldo; bool basef32;
    __device__ __forceinline__ void operator()(const f32x4 (&acc)[2][2][4][2], const Unit& u, int wr, int wc, int fr, int fq) const {
        const int row0 = u.pm * BM + wr * 64 + fr, col0 = u.pn * BM + wc * 32 + 4 * fq;
#pragma unroll
        for (int ai = 0; ai < 2; ++ai) { f32x4 bs[4][2][2];
#pragma unroll
            for (int m = 0; m < 4; ++m) { const size_t off = (size_t)(row0 + ai * HALF + m * 16) * ldb + col0;
#pragma unroll
                for (int bj = 0; bj < 2; ++bj)
#pragma unroll
                    for (int n = 0; n < 2; ++n) bs[m][bj][n] = basef32 ? *(const f32x4*)((const float*)base + off + bj * HALF + n * 16) : ld4_bf16((const bf16_t*)base + off + bj * HALF + n * 16); }
#pragma unroll
            for (int m = 0; m < 4; ++m) { const size_t off = (size_t)(row0 + ai * HALF + m * 16) * ldo + col0;
#pragma unroll
                for (int bj = 0; bj < 2; ++bj)
#pragma unroll
                    for (int n = 0; n < 2; ++n) st4_bf16(out + off + bj * HALF + n * 16, bs[m][bj][n] + acc[ai][bj][m][n]); } }
    }
};
struct EpiResNorm {
    static constexpr bool PERM = false;
    bf16_t* x; int ldc; const float* gain; void* Hn; int ldh; unsigned long long* ss; float ascale; float h8scale;
    __device__ __forceinline__ void operator()(const f32x4 (&acc)[2][2][4][2], const Unit& u, int wr, int wc, int fr, int fq) const {
        const int row0 = u.pm * BM + wr * 64 + fr, col0 = u.pn * BM + wc * 32 + 4 * fq;
        f32x4 gv[2][2];
#pragma unroll
        for (int bj = 0; bj < 2; ++bj)
#pragma unroll
            for (int n = 0; n < 2; ++n) gv[bj][n] = *(const f32x4*)(gain + col0 + bj * HALF + n * 16);
#pragma unroll
        for (int ai = 0; ai < 2; ++ai) { f32x4 bs[4][2][2];
#pragma unroll
            for (int m = 0; m < 4; ++m) { const size_t off = (size_t)(row0 + ai * HALF + m * 16) * ldc + col0;
#pragma unroll
                for (int bj = 0; bj < 2; ++bj)
#pragma unroll
                    for (int n = 0; n < 2; ++n) bs[m][bj][n] = ld4_bf16(x + off + bj * HALF + n * 16); }
#pragma unroll
            for (int m = 0; m < 4; ++m) { const int row = row0 + ai * HALF + m * 16; const size_t off = (size_t)row * ldc + col0, offh = (size_t)row * ldh + col0; float sq = 0.f;
#pragma unroll
                for (int bj = 0; bj < 2; ++bj)
#pragma unroll
                    for (int n = 0; n < 2; ++n) { const f32x4 v = st4_bf16(x + off + bj * HALF + n * 16, bs[m][bj][n] + acc[ai][bj][m][n] * ascale);
                        sq += (v[0] * v[0] + v[1] * v[1]) + (v[2] * v[2] + v[3] * v[3]); const f32x4 hv = v * gv[bj][n];
                        if (h8scale > 0.f) *(unsigned*)((unsigned char*)Hn + offh + bj * HALF + n * 16) = pk4_i8(hv[0] * h8scale, hv[1] * h8scale, hv[2] * h8scale, hv[3] * h8scale);
                        else { typedef unsigned u32x2v __attribute__((ext_vector_type(2))); u32x2v w; w.x = cvt_pk_bf16(hv[0], hv[1]); w.y = cvt_pk_bf16(hv[2], hv[3]); *(u32x2v*)((bf16_t*)Hn + offh + bj * HALF + n * 16) = w; } }
                sq += __shfl_xor(sq, 16); sq += __shfl_xor(sq, 32);
                if (fq == 0) atomicAdd(ss + row, (unsigned long long)(sq * 16777216.0f + 0.5f)); } }
    }
};
struct EpiScatter {
    static constexpr bool PERM = false;
    bf16_t* X; bf16_t* Y; int ldx, ldy; const int* rowtok; const float* rowgate; float scale; float* dummy; int ysplit;
    __device__ __forceinline__ void operator()(const f32x4 (&acc)[2][2][4][2], const Unit& u, int wr, int wc, int fr, int fq) const {
        const int row0 = u.pm * BM + wr * 64 + fr, col0 = u.pn * BM + wc * 32 + 4 * fq;
        int tok[2][4]; float gt[2][4];
#pragma unroll
        for (int ai = 0; ai < 2; ++ai)
#pragma unroll
            for (int m = 0; m < 4; ++m) { const int r = row0 + ai * HALF + m * 16; tok[ai][m] = rowtok[r]; gt[ai][m] = rowgate[r] * scale; }
        if (u.pm < ysplit) {
#pragma unroll
        for (int ai = 0; ai < 2; ++ai) { f32x4 bs[4][2][2]; bf16_t* xp[4];
#pragma unroll
            for (int m = 0; m < 4; ++m) xp[m] = (tok[ai][m] >= 0 ? X + (size_t)tok[ai][m] * ldx : (bf16_t*)dummy) + col0;
#pragma unroll
            for (int m = 0; m < 4; ++m)
#pragma unroll
                for (int bj = 0; bj < 2; ++bj)
#pragma unroll
                    for (int n = 0; n < 2; ++n) bs[m][bj][n] = ld4_bf16(xp[m] + bj * HALF + n * 16);
#pragma unroll
            for (int m = 0; m < 4; ++m)
#pragma unroll
                for (int bj = 0; bj < 2; ++bj)
#pragma unroll
                    for (int n = 0; n < 2; ++n) st4_bf16(xp[m] + bj * HALF + n * 16, bs[m][bj][n] + gt[ai][m] * acc[ai][bj][m][n]); }
        } else {
#pragma unroll
        for (int ai = 0; ai < 2; ++ai)
#pragma unroll
            for (int m = 0; m < 4; ++m) { bf16_t* yp = (tok[ai][m] >= 0 ? Y + (size_t)tok[ai][m] * ldy : (bf16_t*)dummy) + col0;
#pragma unroll
                for (int bj = 0; bj < 2; ++bj)
#pragma unroll
                    for (int n = 0; n < 2; ++n) st4_bf16(yp + bj * HALF + n * 16, gt[ai][m] * acc[ai][bj][m][n]); }
        }
    }
};

struct EpiSlab {
    static constexpr bool PERM = false;
    float* slab;
    __device__ __forceinline__ void operator()(const f32x4 (&acc)[2][2][4][2], const Unit& u, int wr, int wc, int fr, int fq) const {
        float* sp = slab + (size_t)u.sub * 65536 + (size_t)(wr * 64 + fr) * 256 + wc * 32 + 4 * fq;
#pragma unroll
        for (int ai = 0; ai < 2; ++ai)
#pragma unroll
            for (int m = 0; m < 4; ++m)
#pragma unroll
                for (int bj = 0; bj < 2; ++bj)
#pragma unroll
                    for (int n = 0; n < 2; ++n) *(f32x4*)(sp + (size_t)(ai * HALF + m * 16) * 256 + bj * HALF + n * 16) = acc[ai][bj][m][n];
    }
};

#ifndef PG8_SP2
#define PG8_SP2 true
#endif
template <class Epi, class Sched, bool GATHER, bool KSPLIT = false, int FP8 = 0, bool SP2 = PG8_SP2>
__device__ __forceinline__ void gemm_phase(PG8_LAS unsigned char* lds, const Gemm g, const Sched& S, const Epi& E, int wave_id) {
    int lane; asm volatile("v_mbcnt_lo_u32_b32 %0, -1, 0\n\tv_mbcnt_hi_u32_b32 %0, -1, %0" : "=v"(lane));
    int z_ = 0; asm volatile("" : "+v"(z_)); z_ = __builtin_amdgcn_readfirstlane(z_);
    const int wid = wave_id + z_, tid = wid * 64 + lane, wr = wid >> 2, wc = wid & 3, fr = lane & 15, fq = lane >> 4;
    constexpr int ESZ = FP8 != 0 ? 1 : 2;
    const int K = g.K * ESZ / 2, nt = g.klen * ESZ / (BK * 2);
    unsigned voffA[2], voffB[2]; int gR[2], gC2[2];
#pragma unroll
    for (int i = 0; i < 2; ++i) { int R, C; stage_rc(tid * 16 + i * 8192, R, C); const int Rb = Epi::PERM ? ((R & ~31) + perm32(R & 31)) : R;
        voffA[i] = (unsigned)(R * K + C) * 2u; voffB[i] = (unsigned)(Rb * K + C) * 2u; gR[i] = R; gC2[i] = C * 2; }
    const size_t kstep = (size_t)(BK * 2);
    const size_t hstep = (size_t)HALF * K * 2;
    const size_t tstep = 2 * hstep;
    const unsigned ldsw = (unsigned)wid * 1024u;
    const int aoff = lds_byte(wr * 64 + fr, fq * 8), boff = lds_byte(wc * 32 + fr, fq * 8);
    unsigned cv[2][2] = {{0u, 0u}, {0u, 0u}}, nv[2][2] = {{0u, 0u}, {0u, 0u}};
#define PG8_SA(b, h) (((b) * 2 + (h)) * HTB)
#define PG8_SB(b, h) ((4 + (b) * 2 + (h)) * HTB)
#define PG8_STAGEX(bufoff, gbase, voff, aux) do { _Pragma("unroll") for (int _i = 0; _i < 2; ++_i) \
        __builtin_amdgcn_global_load_lds((const unsigned*)((const char*)(gbase) + (voff)[_i]), (PG8_LAS unsigned*)(lds + (bufoff) + ldsw + _i * 8192), 16, 0, aux); } while (0)
#define PG8_STAGE(bufoff, gbase, voff) PG8_STAGEX(bufoff, gbase, voff, 0)
#define PG8_STAGE_A(b, h, kptr, usen) do { if constexpr (GATHER) { _Pragma("unroll") for (int _i = 0; _i < 2; ++_i) { const unsigned _vo = (usen) ? nv[h][_i] : cv[h][_i]; \
        __builtin_amdgcn_global_load_lds((const unsigned*)((const char*)(kptr) + _vo), (PG8_LAS unsigned*)(lds + PG8_SA(b, h) + ldsw + _i * 8192), 16, 0, 0); } } \
        else { PG8_STAGEX(PG8_SA(b, h), (kptr) + (h) * hstep, voffA, 0); } } while (0)
#define PG8_ROWS(dst, unit) do { _Pragma("unroll") for (int _h = 0; _h < 2; ++_h) _Pragma("unroll") for (int _i = 0; _i < 2; ++_i) { int _t = g.rows[(unit).pm * BM + _h * HALF + gR[_i]]; _t = _t < 0 ? 0 : _t; \
        dst[_h][_i] = (unsigned)_t * (unsigned)(K * 2) + (unsigned)gC2[_i]; } } while (0)
#define PG8_ROWL_OFF (STAGE_BYTES + 4096)
#define PG8_ROWS_LDS(dst) do { _Pragma("unroll") for (int _h = 0; _h < 2; ++_h) _Pragma("unroll") for (int _i = 0; _i < 2; ++_i) { int _t = *(const PG8_LAS int*)(lds + PG8_ROWL_OFF + wid * 1024 + (_h * HALF + gR[_i]) * 4); _t = _t < 0 ? 0 : _t; \
        dst[_h][_i] = (unsigned)_t * (unsigned)(K * 2) + (unsigned)gC2[_i]; } } while (0)
#define PG8_LDA(dst, b, h) do { _Pragma("unroll") for (int m = 0; m < 4; ++m) { if constexpr (FP8 == 2) { const i32x4 _l = *(const PG8_LAS i32x4*)(lds + PG8_SA(b, h) + aoff + m * 2048), _h = *(const PG8_LAS i32x4*)(lds + PG8_SA(b, h) + aoff + m * 2048 + 1024); \
        dst##8[m] = __builtin_shufflevector(_l, _h, 0, 1, 2, 3, 4, 5, 6, 7); } else { _Pragma("unroll") for (int k = 0; k < 2; ++k) dst[m][k] = *(const PG8_LAS bf16x8*)(lds + PG8_SA(b, h) + aoff + m * 2048 + k * 1024); } } } while (0)
#define PG8_LDB(dst, b, h) do { _Pragma("unroll") for (int n = 0; n < 2; ++n) { if constexpr (FP8 == 2) { const i32x4 _l = *(const PG8_LAS i32x4*)(lds + PG8_SB(b, h) + boff + n * 2048), _h = *(const PG8_LAS i32x4*)(lds + PG8_SB(b, h) + boff + n * 2048 + 1024); \
        dst##8[n] = __builtin_shufflevector(_l, _h, 0, 1, 2, 3, 4, 5, 6, 7); } else { _Pragma("unroll") for (int k = 0; k < 2; ++k) dst[n][k] = *(const PG8_LAS bf16x8*)(lds + PG8_SB(b, h) + boff + n * 2048 + k * 1024); } } } while (0)
#define PG8_MMA(ai, bj, At, Bt) do { __builtin_amdgcn_s_setprio(1); \
        if constexpr (FP8 == 3) { _Pragma("unroll") for (int k = 0; k < 2; ++k) _Pragma("unroll") for (int m = 0; m < 4; ++m) _Pragma("unroll") for (int n = 0; n < 2; ++n) \
            asm volatile("s_nop 1\n\tv_mfma_i32_16x16x64_i8 %0, %1, %2, %0" : "+v"(acc[ai][bj][m][n]) : "v"(Bt[n][k]), "v"(At[m][k])); } \
        _Pragma("unroll") for (int m = 0; m < 4; ++m) _Pragma("unroll") for (int n = 0; n < 2; ++n) { \
        if constexpr (FP8 == 2) { asm volatile("s_nop 1\n\tv_mfma_scale_f32_16x16x128_f8f6f4 %0, %1, %2, %0, %3, %3 op_sel_hi:[0,0,0]" : "+v"(acc[ai][bj][m][n]) : "v"(Bt##8[n]), "v"(At##8[m]), "v"(mxscale)); } \
        else _Pragma("unroll") for (int k = 0; k < 2; ++k) { \
        if constexpr (FP8 == 3) { } \
        else if constexpr (FP8 == 1) { const i64x2 a8 = __builtin_bit_cast(i64x2, At[m][k]), b8 = __builtin_bit_cast(i64x2, Bt[n][k]); \
            acc[ai][bj][m][n] = __builtin_amdgcn_mfma_f32_16x16x32_fp8_fp8(b8[0], a8[0], acc[ai][bj][m][n], 0, 0, 0); acc[ai][bj][m][n] = __builtin_amdgcn_mfma_f32_16x16x32_fp8_fp8(b8[1], a8[1], acc[ai][bj][m][n], 0, 0, 0); } \
        else acc[ai][bj][m][n] = __builtin_amdgcn_mfma_f32_16x16x32_bf16(Bt[n][k], At[m][k], acc[ai][bj][m][n], 0, 0, 0); } } __builtin_amdgcn_s_setprio(0); } while (0)
#define PG8_MMAQ(ai, bj, At, Bt) PG8_MMA(ai, bj, At, Bt)
#define PG8_WAIT_V(n) asm volatile("s_waitcnt vmcnt(" #n ")" ::: "memory")
#define PG8_WAIT_L(n) asm volatile("s_waitcnt lgkmcnt(" #n ")" ::: "memory")
#define PG8_BAR __builtin_amdgcn_s_barrier()
#define PG8_SCHED __builtin_amdgcn_sched_barrier(0)
    Unit cur, nxt; int ui = 0;
    if (!S.next(0, cur, z_)) return;
    f32x4 acc[2][2][4][2];
#pragma unroll
    for (int a = 0; a < 2; ++a)
#pragma unroll
        for (int b = 0; b < 2; ++b)
#pragma unroll
            for (int m = 0; m < 4; ++m)
#pragma unroll
                for (int n = 0; n < 2; ++n) acc[a][b][m][n] = (f32x4){0.f, 0.f, 0.f, 0.f};
    bf16x8 At[4][2], B0[2][2], B1[2][2];
    i32x8 At8[4], B08[2], B18[2];
    const int mxscale = 0x7f7f7f7f;
    const size_t kqb = KSPLIT ? (size_t)g.klen * ESZ : 0;
    const char* cA = GATHER ? (const char*)g.A : (const char*)g.A + (size_t)cur.pm * tstep + cur.kq * kqb;
    const char* cB = (const char*)g.Bt + ((size_t)cur.e * g.bstride) * ESZ + (size_t)cur.pn * tstep + cur.kq * kqb;
    if constexpr (GATHER) { PG8_ROWS(cv, cur); }
    if constexpr (SP2) {
    PG8_STAGE(PG8_SB(0, 0), cB, voffB); PG8_STAGE(PG8_SB(0, 1), cB + hstep, voffB); PG8_STAGE_A(0, 0, cA, false); PG8_STAGE_A(0, 1, cA, false);
    if (wr == 1) PG8_BAR;
    PG8_WAIT_V(2); PG8_BAR;
    PG8_STAGE(PG8_SB(1, 0), cB + kstep, voffB); PG8_STAGE_A(1, 0, cA + kstep, false); PG8_STAGE(PG8_SB(1, 1), cB + hstep + kstep, voffB);
    PG8_WAIT_V(6); PG8_BAR;
    } else {
    PG8_STAGE(PG8_SB(0, 0), cB, voffB); PG8_STAGE_A(0, 0, cA, false); PG8_STAGE(PG8_SB(0, 1), cB + hstep, voffB); PG8_STAGE_A(0, 1, cA, false);
    if (wr == 1) PG8_BAR;
    PG8_WAIT_V(4); PG8_BAR;
    PG8_STAGE(PG8_SB(1, 0), cB + kstep, voffB); PG8_STAGE_A(1, 0, cA + kstep, false); PG8_STAGE(PG8_SB(1, 1), cB + hstep + kstep, voffB);
    PG8_WAIT_V(6); PG8_BAR;
    }
    for (;;) {
        const bool has_next = S.next(ui + 1, nxt, z_);
        const char* nA = (has_next && !GATHER) ? (const char*)g.A + (size_t)nxt.pm * tstep + nxt.kq * kqb : cA;
        const char* nB = has_next ? (const char*)g.Bt + ((size_t)nxt.e * g.bstride) * ESZ + (size_t)nxt.pn * tstep + nxt.kq * kqb : cB;
        if constexpr (GATHER) { if (has_next) __builtin_amdgcn_global_load_lds((const unsigned*)(g.rows + (size_t)nxt.pm * BM + 4 * lane), (PG8_LAS unsigned*)(lds + PG8_ROWL_OFF + wid * 1024), 16, 0, 0); }
        for (int t = 0; t < nt; t += 2) {
            const bool last = (t == nt - 2);
            const bool un = last && has_next;
            const char* a1 = cA + (size_t)(t + 1) * kstep;
            const char* a2 = last ? nA : cA + (size_t)(t + 2) * kstep; const char* b2 = last ? nB : cB + (size_t)(t + 2) * kstep;
            const char* a3 = a2 + kstep; const char* b3 = b2 + kstep;
            if constexpr (GATHER) { if (un) { PG8_ROWS_LDS(nv); } }
            if constexpr (SP2) {
            PG8_LDB(B0, 0, 0); PG8_LDB(B1, 0, 1); PG8_SCHED; PG8_LDA(At, 0, 0); PG8_STAGE_A(1, 1, a1, false);
            PG8_WAIT_V(8); PG8_WAIT_L(0); PG8_BAR; PG8_MMAQ(0, 0, At, B0); PG8_MMAQ(0, 1, At, B1); PG8_BAR; PG8_SCHED;
            PG8_LDA(At, 0, 1); PG8_STAGE(PG8_SB(0, 0), b2, voffB); PG8_STAGE(PG8_SB(0, 1), b2 + hstep, voffB); PG8_STAGE_A(0, 0, a2, un);
            PG8_WAIT_V(8); PG8_WAIT_L(0); PG8_BAR; PG8_MMAQ(1, 0, At, B0); PG8_MMAQ(1, 1, At, B1); PG8_BAR; PG8_SCHED;
            PG8_LDB(B0, 1, 0); PG8_LDB(B1, 1, 1); PG8_SCHED; PG8_LDA(At, 1, 0); PG8_STAGE_A(0, 1, a2, un);
            PG8_WAIT_V(8); PG8_WAIT_L(0); PG8_BAR; PG8_MMAQ(0, 0, At, B0); PG8_MMAQ(0, 1, At, B1); PG8_BAR; PG8_SCHED;
            PG8_LDA(At, 1, 1); PG8_STAGE(PG8_SB(1, 0), b3, voffB); PG8_STAGE(PG8_SB(1, 1), b3 + hstep, voffB); PG8_STAGE_A(1, 0, a3, un);
            PG8_WAIT_V(8); PG8_WAIT_L(0); PG8_BAR; PG8_MMAQ(1, 0, At, B0); PG8_MMAQ(1, 1, At, B1); PG8_BAR; PG8_SCHED;
            } else {
            PG8_LDB(B0, 0, 0); PG8_SCHED; PG8_LDA(At, 0, 0); PG8_STAGE_A(1, 1, a1, false);
            PG8_WAIT_L(8); PG8_BAR; PG8_WAIT_L(0); PG8_MMAQ(0, 0, At, B0); PG8_BAR; PG8_SCHED;
            PG8_LDB(B1, 0, 1); PG8_STAGE(PG8_SB(0, 0), b2, voffB);
            PG8_BAR; PG8_WAIT_L(0); PG8_MMAQ(0, 1, At, B1); PG8_BAR;
            PG8_LDA(At, 0, 1); PG8_STAGE_A(0, 0, a2, un);
            PG8_BAR; PG8_WAIT_L(0); PG8_MMAQ(1, 0, At, B0); PG8_BAR; PG8_SCHED;
            PG8_STAGE(PG8_SB(0, 1), b2 + hstep, voffB);
            PG8_WAIT_V(6); PG8_BAR; PG8_MMAQ(1, 1, At, B1); PG8_BAR;
            PG8_LDB(B0, 1, 0); PG8_SCHED; PG8_LDA(At, 1, 0); PG8_STAGE_A(0, 1, a2, un);
            PG8_WAIT_L(8); PG8_BAR; PG8_WAIT_L(0); PG8_MMAQ(0, 0, At, B0); PG8_BAR; PG8_SCHED;
            PG8_LDB(B1, 1, 1); PG8_STAGE(PG8_SB(1, 0), b3, voffB);
            PG8_BAR; PG8_WAIT_L(0); PG8_MMAQ(0, 1, At, B1); PG8_BAR;
            PG8_LDA(At, 1, 1); PG8_STAGE_A(1, 0, a3, un);
            PG8_BAR; PG8_WAIT_L(0); PG8_MMAQ(1, 0, At, B0); PG8_BAR; PG8_SCHED;
            PG8_STAGE(PG8_SB(1, 1), b3 + hstep, voffB);
            PG8_WAIT_V(6); PG8_BAR; PG8_MMAQ(1, 1, At, B1); PG8_BAR;
            }
        }
        if constexpr (FP8 == 2) asm volatile("s_nop 15\n\ts_nop 15" ::: "memory");
        if constexpr (FP8 == 3) asm volatile("s_nop 15\n\ts_nop 15\n\ts_nop 15\n\ts_nop 15\n\ts_nop 15\n\ts_nop 15" ::: "memory");
        if constexpr (FP8 == 3) {
#pragma unroll
            for (int a = 0; a < 2; ++a)
#pragma unroll
                for (int b = 0; b < 2; ++b)
#pragma unroll
                    for (int m = 0; m < 4; ++m)
#pragma unroll
                        for (int n = 0; n < 2; ++n)
                            { const i32x4 t_ = __builtin_bit_cast(i32x4, acc[a][b][m][n]); acc[a][b][m][n] = __builtin_convertvector(t_, f32x4); } }
        if (wr == 0) PG8_BAR;
        E(acc, cur, wr, wc, fr, fq);
        if (!has_next) break;
#pragma unroll
        for (int a = 0; a < 2; ++a)
#pragma unroll
            for (int b = 0; b < 2; ++b)
#pragma unroll
                for (int m = 0; m < 4; ++m)
#pragma unroll
                    for (int n = 0; n < 2; ++n) acc[a][b][m][n] = (f32x4){0.f, 0.f, 0.f, 0.f};
        cur = nxt; cA = nA; cB = nB; ++ui;
        if constexpr (GATHER) {
#pragma unroll
            for (int h = 0; h < 2; ++h) { cv[h][0] = nv[h][0]; cv[h][1] = nv[h][1]; } }
        if (wr == 1) PG8_BAR;
    }
    PG8_WAIT_V(0);
    PG8_BAR;
#undef PG8_SA
#undef PG8_SB
#undef PG8_STAGE
#undef PG8_STAGEX
#undef PG8_STAGE_A
#undef PG8_ROWS
#undef PG8_ROWS_LDS
#undef PG8_ROWL_OFF
#undef PG8_LDA
#undef PG8_LDB
#undef PG8_MMA
#undef PG8_MMAQ
#undef PG8_WAIT_V
#undef PG8_WAIT_L
#undef PG8_BAR
#undef PG8_SCHED
}
}
constexpr int BATCH = 8, SEQ = 4096, T = BATCH * SEQ, D = 1024, NIN = 3200, NINP = 3328, FF = 3584, NE = 8, NH = 6;
constexpr int COL_RQ = 0, COL_RK = 384, COL_RV = 768, COL_RG = 1152, COL_MQ = 1536, COL_MK = 1920, COL_MV = 2304, COL_GU = 2688, COL_GV = 2944;
constexpr int MOE_TILES = 136, MOE_ROWS = MOE_TILES * 256;
constexpr float LOG2E = 1.4426950408889634f;
#ifndef DENSE_GU_I8
#define DENSE_GU_I8 1
#endif
constexpr float AI8_SCALE = 32.0f, WI8_SCALE = 1024.0f;
constexpr int XLD = 2 * D;
#ifndef MOE_GU_I8
#define MOE_GU_I8 1
#endif
#ifndef WIN_I8
#define WIN_I8 1
#endif
constexpr float HI8_SCALE = 16.0f;
#ifndef DENSE_DN_FP8
#define DENSE_DN_FP8 1
#endif
#ifndef DENSE_GU_FP8
#define DENSE_GU_FP8 1
#endif
constexpr float W8_SCALE = 32.0f, A8_SCALE = 8.0f;
constexpr int NWAVES = 8;

constexpr size_t MiB = 1u << 20;
constexpr size_t WS_CTL = 0, CTL_ZERO_BYTES = 1 * MiB;
constexpr size_t WS_MISC = 1 * MiB;
constexpr size_t WS_WIN0 = 5 * MiB, WIN_BYTES = (size_t)NINP * D * 2, WS_WIN1 = WS_WIN0 + WIN_BYTES;
constexpr size_t WS_WDN0F8 = 99 * MiB;
constexpr size_t WS_SLAB = 103 * MiB;
constexpr size_t WS_WOUT0 = 18 * MiB, WS_WOUT1 = 20 * MiB;
constexpr size_t WS_WGU0 = 22 * MiB, WS_WDN0 = 36 * MiB;
constexpr size_t WS_WGU1 = 43 * MiB, WS_WDN1 = 155 * MiB;
constexpr size_t WS_H = 211 * MiB;
constexpr size_t WS_BIG = 275 * MiB;
constexpr size_t BIG_STATE = (size_t)T * NINP * 2;
constexpr size_t WS_END = 513 * MiB;
static_assert(WS_WIN1 + WIN_BYTES <= WS_WOUT0 && WS_WGU0 + (size_t)2 * FF * D * 2 <= WS_WDN0 && WS_WDN0 + (size_t)D * FF * 2 <= WS_WGU1, "ws map 1");
static_assert(WS_WGU1 + (size_t)NE * 2 * FF * D * 2 <= WS_WDN1 && WS_WDN1 + (size_t)NE * D * FF * 2 <= WS_H && WS_H + (size_t)T * D * 2 <= WS_BIG, "ws map 2");
static_assert(BIG_STATE + (size_t)BATCH * NH * 32 * 4096 * 4 <= WS_END - WS_BIG && (size_t)MOE_ROWS * FF * 2 <= WS_END - WS_BIG, "ws map 3");
constexpr size_t MS_KMEAN = 0;
constexpr size_t MS_KNORM = 100 * 1024;
constexpr size_t MS_GW = 128 * 1024;
constexpr size_t MS_SEL = 512 * 1024;
constexpr size_t MS_ROWTOK = 1024 * 1024;
constexpr size_t MS_ROWGATE = 1344 * 1024;
constexpr size_t MS_COUNTS = 1664 * 1024;
constexpr size_t MS_DUMMY = 2048 * 1024;
constexpr size_t MS_TILETAB = 1680 * 1024;
static_assert(MS_ROWTOK + 2 * MOE_ROWS * 4 <= MS_ROWGATE && MS_ROWGATE + 2 * MOE_ROWS * 4 <= MS_COUNTS, "misc map");
constexpr int CW_BAR = 4096;
constexpr int CW_MIXQ = 8192;
constexpr int CW_SSQ = 131072;

constexpr int RING_OFF = 0, RING_BYTES = 131072;
constexpr int LDSCTL_OFF = RING_BYTES, MISC_OFF = LDSCTL_OFF + 320;
constexpr int LDS_BYTES = 147456;

#define GAS __attribute__((address_space(1)))
#define LAS __attribute__((address_space(3)))
typedef unsigned short bf16;
typedef unsigned v4u __attribute__((ext_vector_type(4)));
typedef unsigned v2u __attribute__((ext_vector_type(2)));
typedef float f32x4 __attribute__((ext_vector_type(4)));
typedef float f32x16 __attribute__((ext_vector_type(16)));
typedef short bf16x8 __attribute__((ext_vector_type(8)));
typedef short s16x4 __attribute__((ext_vector_type(4)));
typedef GAS unsigned gu32;
#define RLX_AGENT __ATOMIC_RELAXED, __HIP_MEMORY_SCOPE_AGENT
#define LDS_WAIT() asm volatile("s_waitcnt lgkmcnt(0)" ::: "memory")
__device__ __forceinline__ unsigned f2bf(float f) { unsigned u = __builtin_bit_cast(unsigned, f); return (u + 0x7fffu + ((u >> 16) & 1u)) >> 16; }
__device__ __forceinline__ unsigned pk2(float lo, float hi) { return f2bf(lo) | (f2bf(hi) << 16); }
typedef float f32x2_t __attribute__((ext_vector_type(2))); typedef __bf16 bf16x2_t __attribute__((ext_vector_type(2)));
__device__ __forceinline__ unsigned cvtpk(float lo, float hi) { f32x2_t v = {lo, hi}; bf16x2_t b = __builtin_convertvector(v, bf16x2_t); return __builtin_bit_cast(unsigned, b); }
__device__ __forceinline__ unsigned pk4_fp8(float a, float b, float c, float d) {
    a = __builtin_amdgcn_fmed3f(a, -448.f, 448.f); b = __builtin_amdgcn_fmed3f(b, -448.f, 448.f); c = __builtin_amdgcn_fmed3f(c, -448.f, 448.f); d = __builtin_amdgcn_fmed3f(d, -448.f, 448.f);
    unsigned w = 0; w = __builtin_amdgcn_cvt_pk_fp8_f32(a, b, w, false); w = __builtin_amdgcn_cvt_pk_fp8_f32(c, d, w, true); return w; }
__device__ __forceinline__ float bflo(unsigned w) { return __uint_as_float(w << 16); }
__device__ __forceinline__ float bfhi(unsigned w) { return __uint_as_float(w & 0xffff0000u); }
__device__ __forceinline__ f32x4 bf4(v2u w) { return (f32x4){bflo(w.x), bfhi(w.x), bflo(w.y), bfhi(w.y)}; }
__device__ __forceinline__ float readlane_f(float v, int l) { return __int_as_float(__builtin_amdgcn_readlane(__float_as_int(v), l)); }
__device__ __forceinline__ float ex2(float x) { return __builtin_amdgcn_exp2f(x); }
__device__ __forceinline__ f32x16 mfma32(bf16x8 a, bf16x8 b, f32x16 c) { return __builtin_amdgcn_mfma_f32_32x32x16_bf16(a, b, c, 0, 0, 0); }
__device__ __forceinline__ int crow16(int r) { return (r & 3) + 8 * (r >> 2); }
__device__ __forceinline__ s16x4 trd(const LAS unsigned char* p) { return __builtin_bit_cast(s16x4, __builtin_amdgcn_ds_read_tr16_b64_v4i16((LAS s16x4*)p)); }
__device__ __forceinline__ bf16x8 cat8(s16x4 a, s16x4 b) { return (bf16x8){a[0], a[1], a[2], a[3], b[0], b[1], b[2], b[3]}; }
__device__ __forceinline__ bf16x8 packstep(const f32x16& x, int s) {
    v4u w; w.x = cvtpk(x[8 * s], x[8 * s + 1]); w.y = cvtpk(x[8 * s + 2], x[8 * s + 3]); w.z = cvtpk(x[8 * s + 4], x[8 * s + 5]); w.w = cvtpk(x[8 * s + 6], x[8 * s + 7]);
    return __builtin_bit_cast(bf16x8, w);
}
__device__ __forceinline__ float wave_sum(float v) {
#pragma unroll
    for (int o = 1; o < 64; o <<= 1) v += __shfl_xor(v, o);
    return v;
}
__device__ __forceinline__ float gelu_tanh(float x) {
    const float y = 1.5957691216057308f * (x + 0.044715f * x * x * x);
    return x * __builtin_amdgcn_rcpf(1.0f + ex2(-LOG2E * y));
}
__device__ __forceinline__ float silu(float x) { return x * __builtin_amdgcn_rcpf(1.0f + ex2(-LOG2E * x)); }

#define XB_TMO      128
#define XB_XCNT(j)  (256  + 64 * (j))
#define XB_XSUB(j)  (1280 + 64 * (j))
#define XB_XGEN(j)  (2304 + 64 * (j))
#define XB_TOP      3328
#define XB_TOPGEN   3392
#define XCD_BAR_WORDS 3456
#define XB_SPIN_CAP (1u << 18)

__device__ __forceinline__ unsigned xb_ld(unsigned* p)              { return __hip_atomic_load(p, __ATOMIC_RELAXED, __HIP_MEMORY_SCOPE_AGENT); }
__device__ __forceinline__ unsigned xb_add(unsigned* p, unsigned v) { return __hip_atomic_fetch_add(p, v, __ATOMIC_RELAXED, __HIP_MEMORY_SCOPE_AGENT); }
__device__ __forceinline__ unsigned xb_xcc_id() { return (unsigned)__builtin_amdgcn_s_getreg((3 << 11) | 20) & 0xFu; }
#define XB_SPIN(cond, bar) do { unsigned _sp = 0; while (cond) { __builtin_amdgcn_s_sleep(1); \
    if ((++_sp & 255u) == 0u) { if (xb_ld(&(bar)[XB_TMO])) break; if (_sp > XB_SPIN_CAP) { atomicAdd(&(bar)[XB_TMO], 1u); break; } } } } while (0)

struct XcdBarrier {
    unsigned* bar; unsigned x;
    volatile LAS unsigned* st;
};
__device__ __forceinline__ XcdBarrier xcd_barrier_post(unsigned* bar, volatile LAS unsigned* st) {
    XcdBarrier b; b.bar = bar; b.x = xb_xcc_id(); b.st = st;
    if (threadIdx.x == 0) (void)xb_add(&bar[XB_XCNT(b.x)], 1u);
    return b;
}
__device__ __forceinline__ void xcd_barrier_complete(unsigned* bar, unsigned x, unsigned& nloc, unsigned& nx) {
    const unsigned G = gridDim.x * gridDim.y * gridDim.z;
    unsigned sum, cnt, mine, sp = 0u;
    for (;;) {
        sum = 0u; cnt = 0u; mine = 0u;
#pragma unroll
        for (unsigned j = 0; j < 16; ++j) { const unsigned c = xb_ld(&bar[XB_XCNT(j)]); sum += c; cnt += (c > 0u) ? 1u : 0u; mine = (j == x) ? c : mine; }
        if (sum == G) break;
        __builtin_amdgcn_s_sleep(1);
        if ((++sp & 255u) == 0u) { if (xb_ld(&bar[XB_TMO])) break; if (sp > XB_SPIN_CAP) { atomicAdd(&bar[XB_TMO], 1u); break; } }
    }
    nloc = mine > 0u ? mine : 1u; nx = cnt > 0u ? cnt : 1u;
}
__device__ __forceinline__ void xcd_barrier(const XcdBarrier& b) {
    asm volatile("s_waitcnt vmcnt(0)" ::: "memory");
    __syncthreads();
    if (threadIdx.x == 0) {
        unsigned* bar = b.bar;
        __builtin_amdgcn_s_waitcnt(0);
        unsigned nloc = b.st[0], nx = b.st[1];
        if (nloc == 0u) { xcd_barrier_complete(bar, b.x, nloc, nx); b.st[0] = nloc; b.st[1] = nx; }
        const unsigned old = xb_add(&bar[XB_XSUB(b.x)], 1u);
        const unsigned gen = old / nloc;
        if (old + 1u == (gen + 1u) * nloc) {
            __builtin_amdgcn_fence(__ATOMIC_RELEASE, "agent");
            asm volatile("s_waitcnt vmcnt(0)" ::: "memory");
            const unsigned og = xb_add(&bar[XB_TOP], 1u);
            const unsigned tg = og / nx;
            if (og + 1u == (tg + 1u) * nx) xb_add(&bar[XB_TOPGEN], 1u);
            else XB_SPIN(xb_ld(&bar[XB_TOPGEN]) == tg, bar);
            __builtin_amdgcn_fence(__ATOMIC_ACQUIRE, "agent");
            xb_add(&bar[XB_XGEN(b.x)], 1u);
            asm volatile("s_waitcnt vmcnt(0)" ::: "memory");
        } else {
            XB_SPIN(xb_ld(&bar[XB_XGEN(b.x)]) == gen, bar);
            __builtin_amdgcn_fence(__ATOMIC_ACQUIRE, "agent");
            asm volatile("s_waitcnt vmcnt(0)" ::: "memory");
        }
    }
    __syncthreads();
}

struct Frame {
    LAS unsigned char* lds;
    int tid, lane, wave;
    int vcu, G;
};
__device__ __forceinline__ int lane_id_opaque() { int l; asm volatile("v_mbcnt_lo_u32_b32 %0, -1, 0\n\tv_mbcnt_hi_u32_b32 %0, -1, %0" : "=v"(l)); return l; }
__device__ __forceinline__ int zero_opaque() { int z = 0; asm volatile("" : "+v"(z)); return __builtin_amdgcn_readfirstlane(z); }
__device__ __forceinline__ Frame phase_frame(const Frame& F0) { Frame F = F0; const int z = zero_opaque(); F.lane = lane_id_opaque(); F.wave = F0.wave + z; F.tid = F.wave * 64 + F.lane; F.vcu = F0.vcu + z; F.G = F0.G + z; return F; }

__device__ __forceinline__ void transpose_item(const float* W, int K, int N, bf16* WT, int kb, int n0, int drow0, float scale, LAS float* scr, int lane) {
    const int k0 = 64 * kb;
    float v[32];
    { const float* wp = W + (size_t)(k0 + (lane >> 5)) * N + n0 + (lane & 31);
#pragma unroll
      for (int i = 0; i < 32; ++i) v[i] = __builtin_nontemporal_load(wp + (size_t)(2 * i) * N); }
#pragma unroll
    for (int i = 0; i < 32; ++i) { const int kk = 2 * i + (lane >> 5); scr[kk * 33 + (lane & 31)] = v[i]; }
    LDS_WAIT(); asm volatile("" ::: "memory");
    const int c = lane & 7;
#pragma unroll
    for (int j = 0; j < 4; ++j) { const int n = (lane >> 3) + 8 * j; const LAS float* s = scr + (8 * c) * 33 + n;
        v4u o; o.x = pk2(s[0 * 33] * scale, s[1 * 33] * scale); o.y = pk2(s[2 * 33] * scale, s[3 * 33] * scale); o.z = pk2(s[4 * 33] * scale, s[5 * 33] * scale); o.w = pk2(s[6 * 33] * scale, s[7 * 33] * scale);
        *(GAS v4u*)(WT + (size_t)(drow0 + n) * K + k0 + 8 * c) = o; }
    LDS_WAIT(); asm volatile("" ::: "memory");
}
__device__ __forceinline__ void transpose_item8(const float* W, int K, int N, unsigned char* WT, int kb, int n0, int drow0, float scale, LAS float* scr, int lane, bool i8 = false) {
    const int k0 = 64 * kb;
    float v[32];
    { const float* wp = W + (size_t)(k0 + (lane >> 5)) * N + n0 + (lane & 31);
#pragma unroll
      for (int i = 0; i < 32; ++i) v[i] = __builtin_nontemporal_load(wp + (size_t)(2 * i) * N); }
#pragma unroll
    for (int i = 0; i < 32; ++i) { const int kk = 2 * i + (lane >> 5); scr[kk * 33 + (lane & 31)] = v[i]; }
    LDS_WAIT(); asm volatile("" ::: "memory");
    const int c = lane & 7;
#pragma unroll
    for (int j = 0; j < 4; ++j) { const int n = (lane >> 3) + 8 * j; const LAS float* sp = scr + (8 * c) * 33 + n;
        v2u o;
        if (i8) { o.x = pg8::pk4_i8(sp[0 * 33] * scale, sp[1 * 33] * scale, sp[2 * 33] * scale, sp[3 * 33] * scale); o.y = pg8::pk4_i8(sp[4 * 33] * scale, sp[5 * 33] * scale, sp[6 * 33] * scale, sp[7 * 33] * scale); }
        else { o.x = pk4_fp8(sp[0 * 33] * scale, sp[1 * 33] * scale, sp[2 * 33] * scale, sp[3 * 33] * scale); o.y = pk4_fp8(sp[4 * 33] * scale, sp[5 * 33] * scale, sp[6 * 33] * scale, sp[7 * 33] * scale); }
        *(GAS v2u*)(WT + (size_t)(drow0 + n) * K + k0 + 8 * c) = o; }
    LDS_WAIT(); asm volatile("" ::: "memory");
}
__device__ __forceinline__ void rms_row_to_bf16(const float* xrow, const f32x4 (&gn)[4], bf16* orow, int lane) {
    const GAS f32x4* xr = (const GAS f32x4*)xrow + lane;
    f32x4 v[4]; float s = 0.f;
#pragma unroll
    for (int j = 0; j < 4; ++j) { v[j] = xr[64 * j]; s += (v[j].x * v[j].x + v[j].y * v[j].y) + (v[j].z * v[j].z + v[j].w * v[j].w); }
    const float rstd = 1.f / sqrtf(wave_sum(s) * (1.f / D) + 1e-6f);
    GAS unsigned long long* o8 = (GAS unsigned long long*)orow + lane;
#pragma unroll
    for (int j = 0; j < 4; ++j) { const f32x4 y = v[j] * rstd * gn[j]; o8[64 * j] = (unsigned long long)pk2(y.x, y.y) | ((unsigned long long)pk2(y.z, y.w) << 32); }
}
__device__ __forceinline__ void norm_phase(const Frame& F0, const float* x, const float* gain, bf16* H) {
    Frame F = phase_frame(F0);
    f32x4 gn[4];
#pragma unroll
    for (int j = 0; j < 4; ++j) gn[j] = *((const GAS f32x4*)gain + F.lane + 64 * j);
    const int gw = F.vcu * NWAVES + F.wave, NGW = F.G * NWAVES;
    for (int m = gw; m < T; m += NGW) rms_row_to_bf16(x + (size_t)m * D, gn, H + (size_t)m * D, F.lane);
}
__device__ __forceinline__ void norm8_phase(const Frame& F0, const void* x, const float* gain, unsigned char* H8, bool i8 = false, bool xbf = false) {
    Frame F = phase_frame(F0);
    f32x4 gn[4];
#pragma unroll
    for (int j = 0; j < 4; ++j) gn[j] = *((const GAS f32x4*)gain + F.lane + 64 * j);
    const int gw = F.vcu * NWAVES + F.wave, NGW = F.G * NWAVES;
    for (int m = gw; m < T; m += NGW) {
        f32x4 v[4]; float s = 0.f;
        if (xbf) { const GAS v2u* xr = (const GAS v2u*)((const bf16*)x + (size_t)m * XLD) + F.lane;
#pragma unroll
            for (int j = 0; j < 4; ++j) v[j] = bf4(xr[64 * j]); }
        else { const GAS f32x4* xr = (const GAS f32x4*)((const float*)x + (size_t)m * D) + F.lane;
#pragma unroll
            for (int j = 0; j < 4; ++j) v[j] = xr[64 * j]; }
#pragma unroll
        for (int j = 0; j < 4; ++j) s += (v[j].x * v[j].x + v[j].y * v[j].y) + (v[j].z * v[j].z + v[j].w * v[j].w);
        const float rstd = (i8 ? AI8_SCALE : A8_SCALE) / sqrtf(wave_sum(s) * (1.f / D) + 1e-6f);
        GAS unsigned* o8 = (GAS unsigned*)(H8 + (size_t)m * D) + F.lane;
#pragma unroll
        for (int j = 0; j < 4; ++j) { const f32x4 y = v[j] * rstd * gn[j]; o8[64 * j] = i8 ? pg8::pk4_i8(y.x, y.y, y.z, y.w) : pk4_fp8(y.x, y.y, y.z, y.w); } }
}
__device__ __forceinline__ void final_norm_phase(const Frame& F0, float* xo, const bf16* y, const float* gain) {
    Frame F = phase_frame(F0);
    f32x4 gn[4];
#pragma unroll
    for (int j = 0; j < 4; ++j) gn[j] = *((const GAS f32x4*)gain + F.lane + 64 * j);
    const int gw = F.vcu * NWAVES + F.wave, NGW = F.G * NWAVES;
    for (int m = gw; m < T; m += NGW) {
        GAS f32x4* xr = (GAS f32x4*)(xo + (size_t)m * D) + F.lane;
        const GAS v2u* xb = (const GAS v2u*)((const bf16*)xo + (size_t)m * XLD) + F.lane;
        const GAS v2u* yr = (const GAS v2u*)(y + (size_t)m * D) + F.lane;
        f32x4 v[4]; v2u xv[4], yv[4]; float s = 0.f;
#pragma unroll
        for (int j = 0; j < 4; ++j) { xv[j] = xb[64 * j]; yv[j] = yr[64 * j]; }
#pragma unroll
        for (int j = 0; j < 4; ++j) { v[j] = bf4(xv[j]) + bf4(yv[j]);
            s += (v[j].x * v[j].x + v[j].y * v[j].y) + (v[j].z * v[j].z + v[j].w * v[j].w); }
        const float rstd = 1.f / sqrtf(wave_sum(s) * (1.f / D) + 1e-6f);
#pragma unroll
        for (int j = 0; j < 4; ++j) xr[64 * j] = v[j] * rstd * gn[j];
    }
}
#define CAS __attribute__((address_space(4)))
__device__ __forceinline__ const float* arg_in(int k) { const CAS char* ka = (const CAS char*)__builtin_amdgcn_kernarg_segment_ptr(); return *(const float* const volatile CAS*)(ka + 8 * k); }
__device__ __forceinline__ float* arg_out() { const CAS char* ka = (const CAS char*)__builtin_amdgcn_kernarg_segment_ptr(); return *(float* const volatile CAS*)(ka + 8 * 21); }
__device__ __forceinline__ unsigned char* arg_ws() { const CAS char* ka = (const CAS char*)__builtin_amdgcn_kernarg_segment_ptr(); return *(unsigned char* const volatile CAS*)(ka + 8 * 22); }
__device__ __forceinline__ void ffn_item(unsigned char* ws, int mi, int r, LAS float* scr, int lane) {
    const int e = mi < 3 ? 0 : (mi - 3) / 3, kind = mi < 3 ? mi : (mi - 3) % 3;
    if (kind < 2) { const int kb = r / (FF / 32), n0 = 32 * (r % (FF / 32));
        const float* src = mi < 3 ? arg_in(kind ? 8 : 7) : arg_in(kind ? 18 : 17) + (size_t)e * D * FF;
        if (mi < 3) { if (DENSE_GU_FP8) transpose_item8(src, D, FF, ws + WS_WGU0, kb, n0, 256 * (n0 >> 7) + (n0 & 127) + 128 * kind, DENSE_GU_I8 ? WI8_SCALE : W8_SCALE, scr, lane, DENSE_GU_I8 != 0);
                      else transpose_item(src, D, FF, (bf16*)(ws + WS_WGU0), kb, n0, 256 * (n0 >> 7) + (n0 & 127) + 128 * kind, 1.0f, scr, lane); }
        else transpose_item8(src, D, FF, ws + WS_WGU1 + (size_t)e * 2 * FF * D, kb, n0, 256 * (n0 >> 7) + (n0 & 127) + 128 * kind, MOE_GU_I8 ? WI8_SCALE : W8_SCALE, scr, lane, MOE_GU_I8 != 0);
    } else { const int kb = r / (D / 32), n0 = 32 * (r % (D / 32));
        const float* src = mi < 3 ? arg_in(9) : arg_in(19) + (size_t)e * FF * D;
        if (mi < 3) { if (DENSE_DN_FP8 != 1) transpose_item(src, FF, D, (bf16*)(ws + WS_WDN0), kb, n0, n0, 1.0f, scr, lane);
                      if (DENSE_DN_FP8 != 0) transpose_item8(src, FF, D, ws + WS_WDN0F8, kb, n0, n0, W8_SCALE, scr, lane); }
        else transpose_item8(src, FF, D, ws + WS_WDN1 + (size_t)e * D * FF, kb, n0, n0, W8_SCALE, scr, lane); }
}
__device__ __forceinline__ void moe_conv_unit(Frame& F, unsigned char* ws, int cu) {
    LAS float* scr = (LAS float*)(F.lds + RING_OFF + F.wave * 16384);
#pragma unroll 1
    for (int k = 0; k < 3; ++k) { const int it = cu * 24 + F.wave * 3 + k; ffn_item(ws, 3 + it / 1792, it % 1792, scr, F.lane); }
}
__device__ __forceinline__ void prologue_phase(const Frame& F0, unsigned char* ws) {
    Frame F = phase_frame(F0);
    LAS float* scr = (LAS float*)(F.lds + RING_OFF + F.wave * 16384);
    const int gw = F.vcu * NWAVES + F.wave, NGW = F.G * NWAVES;
    constexpr int I_IN = (D / 64) * (NIN / 32), I_OUT = (D / 64) * (D / 32), I_FF = (D / 64) * (FF / 32);
    static_assert((FF / 64) * (D / 32) == I_FF, "down items");
    constexpr int B_OUT = 2 * I_IN, B_FF = B_OUT + 2 * I_OUT, NITEMS = B_FF + 3 * I_FF;
    for (int it = gw; it < NITEMS; it += NGW) {
        if (it < B_OUT) { const int l = it / I_IN, r = it % I_IN, kb = r / (NIN / 32), n0 = 32 * (r % (NIN / 32));
            const float sc = (n0 >= COL_RK && n0 < COL_RV) ? 0.125f : (n0 >= COL_MQ && n0 < COL_MK) ? 0.125f * LOG2E : 1.0f;
            if (WIN_I8) transpose_item8(arg_in(l ? 11 : 2), D, NIN, ws + (l ? WS_WIN1 : WS_WIN0), kb, n0, n0, WI8_SCALE, scr, F.lane, true);
            else transpose_item(arg_in(l ? 11 : 2), D, NIN, (bf16*)(ws + (l ? WS_WIN1 : WS_WIN0)), kb, n0, n0, sc, scr, F.lane);
            continue; }
        if (it < B_FF) { const int l = (it - B_OUT) / I_OUT, r = (it - B_OUT) % I_OUT, kb = r / (D / 32), n0 = 32 * (r % (D / 32));
            transpose_item(arg_in(l ? 12 : 3), D, D, (bf16*)(ws + (l ? WS_WOUT1 : WS_WOUT0)), kb, n0, n0, 1.0f, scr, F.lane); continue; }
        ffn_item(ws, (it - B_FF) / I_FF, (it - B_FF) % I_FF, scr, F.lane);
    }
    const int gt = F.vcu * (NWAVES * 64) + F.tid, NGT = F.G * NWAVES * 64;
    for (int i = gt; i < 2 * 16384; i += NGT) { const int l = i >> 14, p = i & 16383; if (WIN_I8 && p >= 8192) continue; *(GAS v4u*)(ws + (l ? WS_WIN1 : WS_WIN0) + (size_t)NIN * D * (WIN_I8 ? 1 : 2) + (size_t)p * 16) = (v4u){0u, 0u, 0u, 0u}; }
    for (int i = gt; i < 2 * 65536; i += NGT) { const int l = i >> 16, p = i & 65535, row = (p >> 7) & 127, col = p & 127;
        const float w = arg_in(l ? 13 : 4)[p]; ((bf16*)(ws + WS_MISC + MS_GW))[i] = (bf16)(col <= row ? f2bf(w) : 0u); }
}

__device__ __forceinline__ void qk_tile(f32x16& p0, f32x16& p1, const LAS unsigned char* kimg, const bf16x8 (&qf)[4], int r32, int hi) {
    const LAS unsigned char* kb = kimg + hi * 1024 + r32 * 16;
    p0 = (f32x16){0.f, 0.f, 0.f, 0.f, 0.f, 0.f, 0.f, 0.f, 0.f, 0.f, 0.f, 0.f, 0.f, 0.f, 0.f, 0.f}; p1 = p0;
#pragma unroll
    for (int d0 = 0; d0 < 4; ++d0) {
        const bf16x8 a0 = *(const LAS bf16x8*)(kb + d0 * 2048), a1 = *(const LAS bf16x8*)(kb + d0 * 2048 + 512);
        p0 = mfma32(a0, qf[d0], p0); p1 = mfma32(a1, qf[d0], p1); }
}
__device__ __forceinline__ void qk_tile_c(f32x16& p0, f32x16& p1, const f32x16& c0, const f32x16& c1, const LAS unsigned char* kimg, const bf16x8 (&qf)[4], int r32, int hi) {
    const LAS unsigned char* kb = kimg + hi * 1024 + r32 * 16;
    bf16x8 a[8];
#pragma unroll
    for (int d0 = 0; d0 < 4; ++d0) { a[2 * d0] = *(const LAS bf16x8*)(kb + d0 * 2048); a[2 * d0 + 1] = *(const LAS bf16x8*)(kb + d0 * 2048 + 512); }
#pragma unroll
    for (int d0 = 0; d0 < 4; ++d0) { p0 = mfma32(a[2 * d0], qf[d0], d0 ? p0 : c0); p1 = mfma32(a[2 * d0 + 1], qf[d0], d0 ? p1 : c1); }
}
__device__ __forceinline__ void pv_tile(f32x16& o0, f32x16& o1, const LAS unsigned char* vimg, const f32x16& p0, const f32x16& p1, int hi, int q4, int p4, int blk) {
    const LAS unsigned char* vb = vimg + (4 * hi + q4) * 64 + blk * 32 + p4 * 8;
    bf16x8 v0[4], v1[4];
#pragma unroll
    for (int k = 0; k < 4; ++k) { const int ro = (32 * (k >> 1) + 16 * (k & 1)) * 64;
        v0[k] = cat8(trd(vb + ro), trd(vb + ro + 512)); v1[k] = cat8(trd(vb + 4096 + ro), trd(vb + 4096 + ro + 512)); }
#pragma unroll
    for (int k = 0; k < 4; ++k) { const bf16x8 pf = packstep((k >> 1) ? p1 : p0, k & 1);
        o0 = mfma32(v0[k], pf, o0); o1 = mfma32(v1[k], pf, o1); }
}
__device__ __forceinline__ void store_ot(bf16* orow, const f32x16& o0, const f32x16& o1, int hi) {
#pragma unroll
    for (int c2 = 0; c2 < 2; ++c2)
#pragma unroll
        for (int g = 0; g < 4; ++g) { const f32x16& o = c2 ? o1 : o0;
            *(GAS v2u*)(orow + 32 * c2 + 8 * g + 4 * hi) = (v2u){cvtpk(o[4 * g], o[4 * g + 1]), cvtpk(o[4 * g + 2], o[4 * g + 3])}; }
}

#define MB_INIT(P0, P1, KVB) do { const float ct_ = lanesel ? fmaf(slope2, (float)(KVB), cl) - mref : -1e30f; \
    _Pragma("unroll") for (int r = 0; r < 16; ++r) { P0[r] = fmaf(slope2, (float)crow16(r), ct_); P1[r] = fmaf(slope2, (float)(crow16(r) + 32), ct_); } } while (0)
#define MB_SOFTMAX(P0, P1, HASNX, NX0, NX1) do { \
    float mx = fmaxf(fmaxf(P0[0], P0[1]), P1[0]), mx2 = fmaxf(fmaxf(P0[2], P0[3]), P1[1]); mx = fmaxf(fmaxf(mx, P1[2]), P1[3]); \
    _Pragma("unroll") for (int r = 4; r < 16; r += 4) { mx = fmaxf(fmaxf(mx, P0[r]), P0[r + 1]); mx2 = fmaxf(fmaxf(mx2, P0[r + 2]), P0[r + 3]); mx = fmaxf(fmaxf(mx, P1[r]), P1[r + 1]); mx2 = fmaxf(fmaxf(mx2, P1[r + 2]), P1[r + 3]); } \
    mx = fmaxf(mx, mx2); \
    { auto rr = __builtin_amdgcn_permlane32_swap(__float_as_uint(mx), __float_as_uint(mx), false, false); mx = fmaxf(__uint_as_float(rr[0]), __uint_as_float(rr[1])); } \
    if (__builtin_amdgcn_ballot_w64(mx > THR) != 0ull) { const float dl = fmaxf(mx, 0.f); mref += dl; const float f = ex2(-dl); l *= f; \
        _Pragma("unroll") for (int r = 0; r < 16; ++r) { P0[r] -= dl; P1[r] -= dl; o0[r] *= f; o1[r] *= f; if (HASNX) { NX0[r] -= dl; NX1[r] -= dl; } } } \
    float rs = 0.f, rs2 = 0.f; \
    _Pragma("unroll") for (int r = 0; r < 16; ++r) { P0[r] = ex2(P0[r]); P1[r] = ex2(P1[r]); rs += P0[r]; rs2 += P1[r]; } \
    l += rs + rs2; } while (0)
__device__ __forceinline__ void moba_unit(Frame& F, const bf16* proj, bf16* mix, const bf16* kmean, const float* knorm, int b, int h, int ob) {
    const int tid = F.tid, lane = F.lane, wid = F.wave, r32 = lane & 31, hi = lane >> 5, q4 = (lane & 15) >> 2, p4 = lane & 3, blk = (lane >> 4) & 1;
    LAS unsigned char* lds = F.lds + RING_OFF;
    LAS float* wq = (LAS float*)(F.lds + LDSCTL_OFF + 64);
    const int tq = ob * 256 + wid * 32 + r32;
    const bf16* qp = proj + (size_t)(b * SEQ + tq) * NINP + COL_MQ + h * 64 + hi * 8;
    bf16x8 qf[4];
#pragma unroll
    for (int d0 = 0; d0 < 4; ++d0) qf[d0] = *(const bf16x8*)(qp + d0 * 16);
    const float knv = knorm[(size_t)(b * NH + h) * 64 + lane];
    float qn;
    { float qs = 0.f;
#pragma unroll
      for (int d0 = 0; d0 < 4; ++d0)
#pragma unroll
        for (int j = 0; j < 8; ++j) { const float v = __uint_as_float(((unsigned)(unsigned short)qf[d0][j]) << 16); qs += v * v; }
      qs += __shfl_xor(qs, 32); qn = sqrtf(qs) * 1.0001f;
      float wm = qn;
#pragma unroll
      for (int o = 1; o < 32; o <<= 1) wm = fmaxf(wm, __shfl_xor(wm, o));
      if (lane == 0) wq[wid] = wm; }
    unsigned selmask = 0u;
    if (ob > 0) {
        const int kb_ = (r32 & 3) + 4 * (r32 >> 3);
        const bf16* kmp = kmean + ((size_t)((b * NH + h) * 16 + kb_)) * 64 + hi * 8;
        f32x16 sc = (f32x16){0.f, 0.f, 0.f, 0.f, 0.f, 0.f, 0.f, 0.f, 0.f, 0.f, 0.f, 0.f, 0.f, 0.f, 0.f, 0.f};
#pragma unroll
        for (int d0 = 0; d0 < 4; ++d0) sc = mfma32(*(const bf16x8*)(kmp + d0 * 16), qf[d0], sc);
#pragma unroll
        for (int pass = 0; pass < 3; ++pass) { float best = -__builtin_inff(); int bi = -1;
#pragma unroll
            for (int r = 0; r < 16; ++r) { const bool ok = (r < ob) && !((selmask >> r) & 1u) && (sc[r] > best); best = ok ? sc[r] : best; bi = ok ? r : bi; }
            if (bi >= 0) selmask |= 1u << bi; }
    }
    const float slope2 = exp2f(-(8.0f * (float)(h + 1)) / 6.0f) * LOG2E;
    const float cl = -slope2 * (float)(tq - 4 * hi);
    constexpr float THR = 6.0f;
    constexpr float ZERO_AT = -140.0f;
    float mref = 0.f, l = 0.f;
    f32x16 o0 = (f32x16){0.f, 0.f, 0.f, 0.f, 0.f, 0.f, 0.f, 0.f, 0.f, 0.f, 0.f, 0.f, 0.f, 0.f, 0.f, 0.f}, o1 = o0;
    const int sc = wid >> 1;
    const bf16* kvsrc = (wid & 1) ? proj + (size_t)(b * SEQ + sc * 64 + (lane >> 2)) * NINP + COL_MV + h * 64 + 8 * (lane & 3)
                                  : proj + (size_t)(b * SEQ + sc * 64 + lane) * NINP + COL_MK + h * 64;
#define MB_STAGE(JB, BUFB) do { const bf16* sp_ = kvsrc + (size_t)((JB) * 256) * NINP; LAS unsigned char* dp_ = lds + (BUFB) + sc * 16384 + ((wid & 1) ? 8192 : 0); \
        _Pragma("unroll") for (int k_ = 0; k_ < 8; ++k_) { const bf16* g_ = (wid & 1) ? sp_ + (size_t)(16 * (k_ & 3)) * NINP + 32 * (k_ >> 2) : sp_ + 8 * k_; \
            __builtin_amdgcn_global_load_lds((const unsigned*)g_, (LAS unsigned*)(dp_ + ((wid & 1) ? (k_ >> 2) * 4096 + (k_ & 3) * 1024 : k_ * 1024)), 16, 0, 0); } } while (0)
    MB_STAGE(ob, 0);
    asm volatile("s_waitcnt vmcnt(0)" ::: "memory");
    __syncthreads();
    unsigned pastmask = 0u;
    { float qnmax = wq[0];
#pragma unroll
      for (int w = 1; w < 8; ++w) qnmax = fmaxf(qnmax, wq[w]);
      float m4 = fmaxf(knv, __shfl_xor(knv, 1)); m4 = fmaxf(m4, __shfl_xor(m4, 2));
      const float kown = readlane_f(m4, 4 * ob);
      const float mref_lb = fminf(0.f, -(qnmax * kown) - THR);
      for (int jb = 0; jb < ob; ++jb) { const float ub = qnmax * readlane_f(m4, 4 * jb) + slope2 * (float)(jb * 256 + 255 - ob * 256) - mref_lb; if (ub > ZERO_AT) pastmask |= 1u << jb; } }
    int jb = ob;
    for (int it = 0;; ++it) {
        const int bufb = (it & 1) * 65536;
        const int nj = pastmask ? 31 - __builtin_clz(pastmask) : -1;
        if (nj >= 0) MB_STAGE(nj, bufb ^ 65536);
        const bool own = (jb == ob);
        const bool lanesel = own ? true : (((selmask >> jb) & 1u) != 0u);
        bool nd[4];
#pragma unroll
        for (int c = 0; c < 4; ++c) { const int kvb = jb * 256 + c * 64;
            if (own) nd[c] = (2 * c <= wid);
            else { const float ub = fmaf(qn, readlane_f(knv, jb * 4 + c), slope2 * (float)(kvb + 63 - tq)) - mref;
                   nd[c] = __builtin_amdgcn_ballot_w64(lanesel && (ub > ZERO_AT)) != 0ull; } }
        if (!own && nd[0] && nd[1] && nd[2] && nd[3]) {
            f32x16 a0, a1, b0, b1; const int kv0 = jb * 256;
            MB_INIT(a0, a1, kv0); qk_tile_c(a0, a1, a0, a1, lds + bufb, qf, r32, hi);
            MB_INIT(b0, b1, kv0 + 64); qk_tile_c(b0, b1, b0, b1, lds + bufb + 16384, qf, r32, hi);
            MB_SOFTMAX(a0, a1, true, b0, b1); pv_tile(o0, o1, lds + bufb + 8192, a0, a1, hi, q4, p4, blk);
            MB_INIT(a0, a1, kv0 + 128); qk_tile_c(a0, a1, a0, a1, lds + bufb + 32768, qf, r32, hi);
            MB_SOFTMAX(b0, b1, true, a0, a1); pv_tile(o0, o1, lds + bufb + 16384 + 8192, b0, b1, hi, q4, p4, blk);
            MB_INIT(b0, b1, kv0 + 192); qk_tile_c(b0, b1, b0, b1, lds + bufb + 49152, qf, r32, hi);
            MB_SOFTMAX(a0, a1, true, b0, b1); pv_tile(o0, o1, lds + bufb + 32768 + 8192, a0, a1, hi, q4, p4, blk);
            MB_SOFTMAX(b0, b1, false, a0, a1); pv_tile(o0, o1, lds + bufb + 49152 + 8192, b0, b1, hi, q4, p4, blk);
        } else {
#pragma unroll 1
        for (int c = 0; c < 4; ++c) {
            const int kvb = jb * 256 + c * 64, buf = bufb + c * 16384;
            const bool need = c == 0 ? nd[0] : c == 1 ? nd[1] : c == 2 ? nd[2] : nd[3];
            if (need) {
                f32x16 p0, p1;
                MB_INIT(p0, p1, kvb);
                qk_tile_c(p0, p1, p0, p1, lds + buf, qf, r32, hi);
                if (own && (2 * c + 1 >= wid)) {
                    const int dq = tq - kvb - 4 * hi;
#pragma unroll
                    for (int r = 0; r < 16; ++r) { p0[r] = (crow16(r) <= dq) ? p0[r] : -1e30f; p1[r] = (crow16(r) + 32 <= dq) ? p1[r] : -1e30f; }
                }
                MB_SOFTMAX(p0, p1, false, p0, p1);
                pv_tile(o0, o1, lds + buf + 8192, p0, p1, hi, q4, p4, blk);
            }
        }
        }
        asm volatile("s_waitcnt vmcnt(0)" ::: "memory");
        __syncthreads();
        if (nj < 0) break;
        pastmask &= ~(1u << nj); jb = nj;
    }
    l += __shfl_xor(l, 32);
    const float inv = 1.0f / l;
#pragma unroll
    for (int r = 0; r < 16; ++r) { o0[r] *= inv; o1[r] *= inv; }
    store_ot(mix + (size_t)(b * SEQ + tq) * D + 384 + h * 64, o0, o1, hi);
#undef MB_STAGE
}

__device__ __forceinline__ void ret_unit(Frame& F, const bf16* proj, bf16* mix, const float* state, int b, int h, int u) {
    const int tid = F.tid, lane = F.lane, wid = F.wave, r32 = lane & 31, hi = lane >> 5, q4 = (lane & 15) >> 2, p4 = lane & 3, blk = (lane >> 4) & 1;
    LAS unsigned char* lds = F.lds + RING_OFF;
    const int cc = wid >> 2, ww = wid & 3, n = 2 * u + cc, i = 32 * ww + r32;
    const size_t trow = (size_t)(b * SEQ + n * 128 + i);
    const float lg2 = log2f(1.0f - exp2f(-5.0f - (float)h));
    v4u pr[8];
#pragma unroll
    for (int k = 0; k < 8; ++k) { const int p = tid + 512 * k, c_ = p >> 11, kv_ = (p >> 10) & 1, row = (p >> 3) & 127, ch = p & 7;
        pr[k] = *(const GAS v4u*)(proj + (size_t)(b * SEQ + (2 * u + c_) * 128 + row) * NINP + (kv_ ? COL_RV : COL_RK) + h * 64 + ch * 8); }
#pragma unroll
    for (int k = 0; k < 8; ++k) { const int p = tid + 512 * k, c_ = p >> 11, kv_ = (p >> 10) & 1, row = (p >> 3) & 127, ch = p & 7, kvr = row & 63;
        const int dst = c_ * 32768 + (row >> 6) * 16384 + (kv_ ? 8192 + (ch >> 2) * 4096 + kvr * 64 + (ch & 3) * 16 : ch * 1024 + kvr * 16);
        *(LAS v4u*)(lds + dst) = pr[k]; }
    const bf16* qp = proj + trow * NINP + COL_RQ + h * 64 + hi * 8;
    bf16x8 qf[4];
#pragma unroll
    for (int d0 = 0; d0 < 4; ++d0) qf[d0] = *(const bf16x8*)(qp + d0 * 16);
    f32x16 o0 = (f32x16){0.f, 0.f, 0.f, 0.f, 0.f, 0.f, 0.f, 0.f, 0.f, 0.f, 0.f, 0.f, 0.f, 0.f, 0.f, 0.f}, o1 = o0;
    { const float* st = state + ((size_t)((b * NH + h) * 32 + n)) * 4096 + hi * 8;
#pragma unroll
      for (int d0 = 0; d0 < 4; ++d0) {
#pragma unroll
        for (int c2 = 0; c2 < 2; ++c2) { const float* sp = st + (size_t)(32 * c2 + r32) * 64 + d0 * 16;
            const f32x4 a = *(const GAS f32x4*)sp, bq = *(const GAS f32x4*)(sp + 4);
            v4u w; w.x = pk2(a.x, a.y); w.y = pk2(a.z, a.w); w.z = pk2(bq.x, bq.y); w.w = pk2(bq.z, bq.w);
            if (c2) o1 = mfma32(__builtin_bit_cast(bf16x8, w), qf[d0], o1); else o0 = mfma32(__builtin_bit_cast(bf16x8, w), qf[d0], o0); } } }
    { const float xi = ex2(lg2 * (float)(i + 1));
#pragma unroll
      for (int r = 0; r < 16; ++r) { o0[r] *= xi; o1[r] *= xi; } }
    __syncthreads();
#pragma unroll 1
    for (int c = 0; c < 2; ++c) {
        if (2 * c <= ww) {
            f32x16 p0, p1;
            const LAS unsigned char* tb = lds + cc * 32768 + c * 16384;
            qk_tile(p0, p1, tb, qf, r32, hi);
            const int dq = i - 64 * c - 4 * hi;
#pragma unroll
            for (int r = 0; r < 16; ++r) { const int d0i = dq - crow16(r), d1i = d0i - 32;
                p0[r] = d0i >= 0 ? p0[r] * ex2(lg2 * (float)d0i) : 0.f; p1[r] = d1i >= 0 ? p1[r] * ex2(lg2 * (float)d1i) : 0.f; }
            pv_tile(o0, o1, tb + 8192, p0, p1, hi, q4, p4, blk);
        }
    }
    float s = 0.f;
#pragma unroll
    for (int r = 0; r < 16; ++r) s += o0[r] + o1[r];
    s += __shfl_xor(s, 32);
    const float mean = s * (1.0f / 64.0f); float vs = 0.f;
#pragma unroll
    for (int r = 0; r < 16; ++r) { o0[r] -= mean; o1[r] -= mean; vs += o0[r] * o0[r] + o1[r] * o1[r]; }
    vs += __shfl_xor(vs, 32);
    const float rstd = 1.0f / sqrtf(vs * (1.0f / 64.0f) + 1e-5f);
    const bf16* gp = proj + trow * NINP + COL_RG + h * 64;
#pragma unroll
    for (int c2 = 0; c2 < 2; ++c2)
#pragma unroll
        for (int g = 0; g < 4; ++g) { const v2u gv = *(const GAS v2u*)(gp + 32 * c2 + 8 * g + 4 * hi); f32x16& o = c2 ? o1 : o0;
            o[4 * g] *= rstd * silu(bflo(gv.x)); o[4 * g + 1] *= rstd * silu(bfhi(gv.x)); o[4 * g + 2] *= rstd * silu(bflo(gv.y)); o[4 * g + 3] *= rstd * silu(bfhi(gv.y)); }
    store_ot(mix + trow * D + h * 64, o0, o1, hi);
    __syncthreads();
}

__device__ __forceinline__ void kv_load(v4u (&pr)[8], int tid, const bf16* proj, int b, int h, int u) {
#pragma unroll
    for (int k = 0; k < 8; ++k) { const int p = tid + 512 * k, c_ = p >> 11, kv_ = (p >> 10) & 1, row = (p >> 3) & 127, ch = p & 7;
        pr[k] = *(const GAS v4u*)(proj + (size_t)(b * SEQ + (2 * u + c_) * 128 + row) * NINP + (kv_ ? COL_RV : COL_RK) + h * 64 + ch * 8); }
}
__device__ __forceinline__ void kv_unit(Frame& F, const v4u (&pr)[8], float* state, int b, int h, int u) {
    const int tid = F.tid, lane = F.lane, wid = F.wave, r32 = lane & 31, hi = lane >> 5, q4 = (lane & 15) >> 2, p4 = lane & 3, blk = (lane >> 4) & 1;
    LAS unsigned char* lds = F.lds + RING_OFF;
    const float lg2 = log2f(1.0f - exp2f(-5.0f - (float)h));
#pragma unroll
    for (int k = 0; k < 8; ++k) { const int p = tid + 512 * k, c_ = p >> 11, kv_ = (p >> 10) & 1, row = (p >> 3) & 127, ch = p & 7;
        v4u w = pr[k];
        if (!kv_) { const float z = ex2(lg2 * (float)(127 - row));
            w.x = pk2(bflo(w.x) * z, bfhi(w.x) * z); w.y = pk2(bflo(w.y) * z, bfhi(w.y) * z); w.z = pk2(bflo(w.z) * z, bfhi(w.z) * z); w.w = pk2(bflo(w.w) * z, bfhi(w.w) * z); }
        *(LAS v4u*)(lds + c_ * 32768 + kv_ * 16384 + (ch >> 2) * 8192 + row * 64 + (ch & 3) * 16) = w; }
    __syncthreads();
    const int cc = wid >> 2, ce = (wid >> 1) & 1, cd = wid & 1, n = 2 * u + cc;
    const LAS unsigned char* kb = lds + cc * 32768 + cd * 8192 + (8 * hi + q4) * 64 + blk * 32 + p4 * 8;
    const LAS unsigned char* vb = lds + cc * 32768 + 16384 + ce * 8192 + (8 * hi + q4) * 64 + blk * 32 + p4 * 8;
    f32x16 acc = (f32x16){0.f, 0.f, 0.f, 0.f, 0.f, 0.f, 0.f, 0.f, 0.f, 0.f, 0.f, 0.f, 0.f, 0.f, 0.f, 0.f};
#pragma unroll
    for (int ks = 0; ks < 8; ++ks) {
        const bf16x8 a = cat8(trd(vb + ks * 1024), trd(vb + ks * 1024 + 256)), bq = cat8(trd(kb + ks * 1024), trd(kb + ks * 1024 + 256));
        acc = mfma32(a, bq, acc); }
    float* sp = state + ((size_t)((b * NH + h) * 32 + n)) * 4096 + (size_t)(32 * ce + 4 * hi) * 64 + 32 * cd + r32;
#pragma unroll
    for (int r = 0; r < 16; ++r) sp[crow16(r) * 64] = acc[r];
    __syncthreads();
}
__device__ __forceinline__ void kmean_unit(Frame& F, const bf16* proj, bf16* kmean, int b, int j) {
    LAS float* red = (LAS float*)(F.lds + RING_OFF);
    const int tid = F.tid;
    if (tid < 384) { const int cp = tid % 192, rg = tid / 192; float a0 = 0.f, a1 = 0.f;
        const bf16* p = proj + (size_t)(b * SEQ + j * 256 + rg * 128) * NINP + COL_MK + 2 * cp;
        for (int r = 0; r < 128; ++r) { const unsigned w = *(const GAS unsigned*)(p + (size_t)r * NINP); a0 += bflo(w); a1 += bfhi(w); }
        red[(rg * 192 + cp) * 2] = a0; red[(rg * 192 + cp) * 2 + 1] = a1; }
    __syncthreads();
    if (tid < 192) { const float m0 = (red[tid * 2] + red[(192 + tid) * 2]) * (1.0f / 256.0f), m1 = (red[tid * 2 + 1] + red[(192 + tid) * 2 + 1]) * (1.0f / 256.0f);
        const int col = 2 * tid, hh = col >> 6, d = col & 63;
        *(GAS unsigned*)(kmean + ((size_t)((b * NH + hh) * 16 + j)) * 64 + d) = pk2(m0, m1); }
    __syncthreads();
}
__device__ __forceinline__ void knorm_unit(Frame& F, const bf16* proj, float* knorm, int b, int j) {
    LAS float* nr = (LAS float*)(F.lds + RING_OFF);
    const int tid = F.tid, row = tid >> 1, h3 = (tid & 1) * 3;
    const bf16* p = proj + (size_t)(b * SEQ + j * 256 + row) * NINP + COL_MK + h3 * 64;
#pragma unroll
    for (int hh = 0; hh < 3; ++hh) { float ss = 0.f;
#pragma unroll
        for (int c = 0; c < 8; ++c) { const v4u w = *(const GAS v4u*)(p + hh * 64 + c * 8);
            ss += bflo(w.x) * bflo(w.x) + bfhi(w.x) * bfhi(w.x) + bflo(w.y) * bflo(w.y) + bfhi(w.y) * bfhi(w.y) + bflo(w.z) * bflo(w.z) + bfhi(w.z) * bfhi(w.z) + bflo(w.w) * bflo(w.w) + bfhi(w.w) * bfhi(w.w); }
        nr[row * 6 + h3 + hh] = ss; }
    __syncthreads();
    if (tid < 24) { const int c = tid / 6, hh = tid % 6; float mxs = 0.f; for (int r = 0; r < 64; ++r) mxs = fmaxf(mxs, nr[(64 * c + r) * 6 + hh]);
        knorm[(size_t)(b * NH + hh) * 64 + j * 4 + c] = sqrtf(mxs) * 1.0001f; }
    __syncthreads();
}
__device__ __forceinline__ void prep_phase(const Frame& F0, const bf16* proj, float* state, bf16* kmean, float* knorm) {
    Frame F = phase_frame(F0);
    { v4u pr[8], prn[8]; int u2 = F.vcu;
      if (u2 < BATCH * NH * 16) kv_load(pr, F.tid, proj, (u2 >> 4) / NH, (u2 >> 4) % NH, u2 & 15);
      for (; u2 < BATCH * NH * 16; u2 += F.G) { const int bh = u2 >> 4, un = u2 + F.G;
          if (un < BATCH * NH * 16) kv_load(prn, F.tid, proj, (un >> 4) / NH, (un >> 4) % NH, un & 15);
          kv_unit(F, pr, state, bh / NH, bh % NH, u2 & 15);
#pragma unroll
          for (int k = 0; k < 8; ++k) pr[k] = prn[k]; } }
    for (int u2 = F.vcu; u2 < BATCH * 16; u2 += F.G) { kmean_unit(F, proj, kmean, u2 >> 4, u2 & 15); knorm_unit(F, proj, knorm, u2 >> 4, u2 & 15); }
}
__device__ __forceinline__ void scan_phase(const Frame& F0, float* state) {
    Frame F = phase_frame(F0);
    const int gt = F.vcu * (NWAVES * 64) + F.tid, NGT = F.G * NWAVES * 64;
    for (int idx = gt; idx < BATCH * NH * 4096; idx += NGT) { const int bh = idx >> 12, el = idx & 4095, h = bh % NH;
        const float cd = exp2f(128.0f * log2f(1.0f - exp2f(-5.0f - (float)h)));
        float* p = state + (size_t)bh * 32 * 4096 + el; float st = 0.f;
        for (int n = 0; n < 32; ++n) { const float kvn = p[(size_t)n * 4096]; p[(size_t)n * 4096] = st; st = st * cd + kvn; } }
}
__device__ __forceinline__ void gmlp_unit(Frame& F, const bf16* proj, bf16* mix, const bf16* gwb, const float* gb, int b, int n) {
    const int lane = F.lane, wid = F.wave, r32 = lane & 31, hi = lane >> 5, q4 = (lane & 15) >> 2, p4 = lane & 3, blk = (lane >> 4) & 1;
    LAS unsigned char* lds = F.lds + RING_OFF;
    v2u rawv[16];
#pragma unroll
    for (int k = 0; k < 16; ++k) rawv[k] = *(const GAS v2u*)(proj + (size_t)(b * SEQ + n * 128 + wid * 16 + k) * NINP + COL_GV + 4 * lane);
#pragma unroll
    for (int k = 0; k < 16; ++k) { const int j = wid * 16 + k;
        const v2u raw = rawv[k];
        float x0 = gelu_tanh(bflo(raw.x)), x1 = gelu_tanh(bfhi(raw.x)), x2 = gelu_tanh(bflo(raw.y)), x3 = gelu_tanh(bfhi(raw.y));
        const float mean = wave_sum((x0 + x1) + (x2 + x3)) * (1.0f / 256.0f);
        x0 -= mean; x1 -= mean; x2 -= mean; x3 -= mean;
        const float rstd = 1.0f / sqrtf(wave_sum((x0 * x0 + x1 * x1) + (x2 * x2 + x3 * x3)) * (1.0f / 256.0f) + 1e-5f);
        const int g = lane >> 4, c = 4 * (lane & 15);
        *(LAS v2u*)(lds + g * 16384 + (c >> 5) * 8192 + j * 64 + (c & 31) * 2) = (v2u){pk2(x0 * rstd, x1 * rstd), pk2(x2 * rstd, x3 * rstd)}; }
    __syncthreads();
    const int g = wid & 3;
    const LAS unsigned char* vb = lds + g * 16384 + (8 * hi + q4) * 64 + blk * 32 + p4 * 8;
    for (int k2 = 0; k2 < 2; ++k2) {
        const int it = (wid >> 2) ? (1 + k2) : (3 * k2);
        const int i = 32 * it + r32;
        f32x16 o0 = (f32x16){0.f, 0.f, 0.f, 0.f, 0.f, 0.f, 0.f, 0.f, 0.f, 0.f, 0.f, 0.f, 0.f, 0.f, 0.f, 0.f}, o1 = o0;
        const bf16* wp = gwb + ((size_t)(g * 128 + i)) * 128 + 8 * hi;
        bf16x8 wfv[8];
#pragma unroll
        for (int s = 0; s < 8; ++s) wfv[s] = *(const bf16x8*)(wp + 16 * s);
#pragma unroll
        for (int s = 0; s < 8; ++s) { if (s >= 2 * it + 2) break;
            const bf16x8 wf = wfv[s];
            const bf16x8 v0 = cat8(trd(vb + s * 1024), trd(vb + s * 1024 + 256)), v1 = cat8(trd(vb + 8192 + s * 1024), trd(vb + 8192 + s * 1024 + 256));
            o0 = mfma32(v0, wf, o0); o1 = mfma32(v1, wf, o1); }
        const float bias = gb[g * 128 + i];
        const size_t trow = (size_t)(b * SEQ + n * 128 + i);
        const bf16* up = proj + trow * NINP + COL_GU + g * 64;
#pragma unroll
        for (int c2 = 0; c2 < 2; ++c2)
#pragma unroll
            for (int gg = 0; gg < 4; ++gg) { const v2u uv = *(const GAS v2u*)(up + 32 * c2 + 8 * gg + 4 * hi); f32x16& o = c2 ? o1 : o0;
                o[4 * gg] = gelu_tanh(bflo(uv.x)) * (o[4 * gg] + bias); o[4 * gg + 1] = gelu_tanh(bfhi(uv.x)) * (o[4 * gg + 1] + bias);
                o[4 * gg + 2] = gelu_tanh(bflo(uv.y)) * (o[4 * gg + 2] + bias); o[4 * gg + 3] = gelu_tanh(bfhi(uv.y)) * (o[4 * gg + 3] + bias); }
        store_ot(mix + trow * D + 768 + g * 64, o0, o1, hi);
    }
    __syncthreads();
}
__device__ __forceinline__ void mixer_phase(const Frame& F0, const bf16* proj, bf16* mix, const float* state, const bf16* kmean, const float* knorm, const bf16* gwb, const float* gb, unsigned* qhead, unsigned char* ws_conv) {
    Frame F = phase_frame(F0);
    constexpr int NMOBA = BATCH * NH * 16, NRET = BATCH * NH * 16, NGM = BATCH * 32, NU = NMOBA + NRET + NGM;
    LAS int* qslot = (LAS int*)(F.lds + LDSCTL_OFF + 128);
    int cur = F.vcu;
#define MIXQ_NEXT() do { if (ws_conv && cur < 1792 - 256) moe_conv_unit(F, ws_conv, 256 + cur); if (F.tid == 0) *qslot = nxt; __syncthreads(); cur = *qslot; } while (0)
#define MIXQ_REQ() int nxt = 0; if (F.tid == 0) nxt = F.G + (int)__hip_atomic_fetch_add(qhead, 1u, __ATOMIC_RELAXED, __HIP_MEMORY_SCOPE_AGENT)
    constexpr int NM1 = 12 * BATCH * NH;
    while (cur < NM1) { MIXQ_REQ();
        const int ob = 15 - cur / (BATCH * NH), q = cur % (BATCH * NH), h = NH - 1 - q / BATCH, b = q % BATCH; moba_unit(F, proj, mix, kmean, knorm, b, h, ob);
        MIXQ_NEXT(); }
    while (cur < NM1 + NGM) { MIXQ_REQ();
        const int u2 = cur - NM1; gmlp_unit(F, proj, mix, gwb, gb, u2 >> 5, u2 & 31);
        MIXQ_NEXT(); }
    while (cur < NMOBA + NGM) { MIXQ_REQ();
        const int c2 = cur - NGM, ob = 15 - c2 / (BATCH * NH), q = c2 % (BATCH * NH), h = NH - 1 - q / BATCH, b = q % BATCH; moba_unit(F, proj, mix, kmean, knorm, b, h, ob);
        MIXQ_NEXT(); }
    while (cur < NU) { MIXQ_REQ();
        const int u2 = cur - NMOBA - NGM, bh = u2 >> 4; ret_unit(F, proj, mix, state, bh / NH, bh % NH, u2 & 15);
        MIXQ_NEXT(); }
#undef MIXQ_NEXT
#undef MIXQ_REQ
}

__device__ __forceinline__ void router_phase(const Frame& F0, const bf16* x, const float* gain, const float* router, bf16* H, v4u* sel, int* counts) {
    Frame F = phase_frame(F0);
    LAS float* Rt = (LAS float*)(F.lds + RING_OFF);
    LAS int* cntw = (LAS int*)(F.lds + RING_OFF + 32768);
    for (int i = F.tid; i < 8192; i += NWAVES * 64) { const int k = i >> 3, e = i & 7; Rt[e * 1024 + k] = router[i]; }
    __syncthreads();
    int cw[16];
#pragma unroll
    for (int q = 0; q < 16; ++q) cw[q] = 0;
    f32x4 gn[4];
#pragma unroll
    for (int j = 0; j < 4; ++j) gn[j] = *((const GAS f32x4*)gain + F.lane + 64 * j);
    const int m0 = F.vcu * 128 + F.wave * 16;
    f32x4 vn[4];
#pragma unroll
    for (int j = 0; j < 4; ++j) vn[j] = bf4(*((const GAS v2u*)(x + (size_t)m0 * XLD) + F.lane + 64 * j));
    const bool up5 = (F.lane & 32) != 0, up4 = (F.lane & 16) != 0, up3 = (F.lane & 8) != 0;
    for (int k = 0; k < 16; ++k) { const int m = m0 + k;
        f32x4 v[4]; float s = 0.f;
#pragma unroll
        for (int j = 0; j < 4; ++j) { v[j] = vn[j]; s += (v[j].x * v[j].x + v[j].y * v[j].y) + (v[j].z * v[j].z + v[j].w * v[j].w); }
        if (k + 1 < 16) {
#pragma unroll
            for (int j = 0; j < 4; ++j) vn[j] = bf4(*((const GAS v2u*)(x + (size_t)(m + 1) * XLD) + F.lane + 64 * j)); }
        const float rstd = 1.f / sqrtf(wave_sum(s) * (1.f / D) + 1e-6f);
        GAS unsigned* o8 = (GAS unsigned*)((unsigned char*)H + (size_t)m * D) + F.lane;
        float lg[8];
#pragma unroll
        for (int e = 0; e < 8; ++e) lg[e] = 0.f;
#pragma unroll
        for (int j = 0; j < 4; ++j) { const f32x4 y = v[j] * rstd * gn[j]; o8[64 * j] = MOE_GU_I8 ? pg8::pk4_i8(y.x * AI8_SCALE, y.y * AI8_SCALE, y.z * AI8_SCALE, y.w * AI8_SCALE) : pk4_fp8(y.x * A8_SCALE, y.y * A8_SCALE, y.z * A8_SCALE, y.w * A8_SCALE);
#pragma unroll
            for (int e = 0; e < 8; ++e) { const f32x4 rr = *(const LAS f32x4*)(Rt + e * 1024 + 256 * j + 4 * F.lane); lg[e] += (y.x * rr.x + y.y * rr.y) + (y.z * rr.z + y.w * rr.w); } }
        float t4[4], t2[2], t1;
#pragma unroll
        for (int i = 0; i < 4; ++i) { const float give = up5 ? lg[i] : lg[4 + i], keep = up5 ? lg[4 + i] : lg[i]; t4[i] = keep + __shfl_xor(give, 32); }
#pragma unroll
        for (int i = 0; i < 2; ++i) { const float give = up4 ? t4[i] : t4[2 + i], keep = up4 ? t4[2 + i] : t4[i]; t2[i] = keep + __shfl_xor(give, 16); }
        { const float give = up3 ? t2[0] : t2[1], keep = up3 ? t2[1] : t2[0]; t1 = keep + __shfl_xor(give, 8); }
        t1 += __shfl_xor(t1, 4); t1 += __shfl_xor(t1, 2); t1 += __shfl_xor(t1, 1);
#pragma unroll
        for (int e = 0; e < 8; ++e) lg[e] = readlane_f(t1, 8 * e);
        int e0 = 0; float v0 = lg[0];
#pragma unroll
        for (int e = 1; e < 8; ++e) if (lg[e] > v0) { v0 = lg[e]; e0 = e; }
        int e1 = -1; float v1 = -__builtin_inff();
#pragma unroll
        for (int e = 0; e < 8; ++e) if (e != e0 && lg[e] > v1) { v1 = lg[e]; e1 = e; }
        const float g0 = 1.0f / (1.0f + expf(v1 - v0)), g1 = 1.0f - g0;
        if (F.lane == 0) sel[m] = (v4u){(unsigned)e0 | ((unsigned)e1 << 8), __float_as_uint(g0), __float_as_uint(g1), 0u};
#pragma unroll
        for (int e = 0; e < 8; ++e) { cw[e] += (e0 == e) ? 1 : 0; cw[8 + e] += (e1 == e) ? 1 : 0; }
    }
    if (F.lane == 0) {
#pragma unroll
        for (int q = 0; q < 16; ++q) cntw[F.wave * 16 + q] = cw[q]; }
    __syncthreads();
    if (F.tid < 16) { int sacc = 0; for (int w2 = 0; w2 < 8; ++w2) sacc += cntw[w2 * 16 + F.tid]; counts[F.vcu * 16 + F.tid] = sacc; }
    __syncthreads();
}
__device__ __forceinline__ void lists_phase(const Frame& F0, const v4u* sel, const int* counts, int* rowtok, float* rowgate, int* tiletab) {
    Frame F = phase_frame(F0);
    LAS int* part = (LAS int*)(F.lds + RING_OFF);
    LAS int* prein = part + 512, *tot = prein + 16, *bef = tot + 16, *gstart = bef + 16, *gbase = gstart + 16;
    const int t = F.tid & 15, pr = F.tid >> 4, w = F.vcu;
    { int sfull = 0, spre = 0;
      for (int k = 0; k < 8; ++k) { const int c = counts[(8 * pr + k) * 16 + t]; sfull += c; if (8 * pr + k < w) spre += c; }
      part[pr * 16 + t] = sfull; if (pr == (w >> 3)) prein[t] = spre; }
    __syncthreads();
    if (F.tid < 16) { int s = 0, bsum = 0; for (int p2 = 0; p2 < 32; ++p2) { const int c = part[p2 * 16 + t]; s += c; if (p2 < (w >> 3)) bsum += c; } tot[t] = s; bef[t] = bsum + prein[t]; }
    __syncthreads();
    if (F.tid < 16) { const int slot = t >> 3, e = t & 7; int gs = 0; for (int e2 = 0; e2 < e; ++e2) gs += (tot[slot * 8 + e2] + 255) & ~255; gstart[t] = gs; gbase[t] = gs + bef[t]; }
    __syncthreads();
    if (F.wave == 0) {
        int run[16];
#pragma unroll
        for (int q = 0; q < 16; ++q) run[q] = 0;
        for (int rd = 0; rd < 2; ++rd) { const int tok = w * 128 + rd * 64 + F.lane; const v4u sv = sel[tok];
            const int e0 = sv.x & 255, e1 = (sv.x >> 8) & 255; int pos0 = 0, pos1 = 0;
            const unsigned long long lt = (1ull << F.lane) - 1ull;
#pragma unroll
            for (int e = 0; e < 8; ++e) {
                const unsigned long long m0 = __builtin_amdgcn_ballot_w64(e0 == e), m1 = __builtin_amdgcn_ballot_w64(e1 == e);
                if (e0 == e) pos0 = gbase[e] + run[e] + __builtin_popcountll(m0 & lt);
                if (e1 == e) pos1 = gbase[8 + e] + run[8 + e] + __builtin_popcountll(m1 & lt);
                run[e] += __builtin_popcountll(m0); run[8 + e] += __builtin_popcountll(m1); }
            rowtok[pos0] = tok; rowgate[pos0] = __uint_as_float(sv.y);
            rowtok[MOE_ROWS + pos1] = tok; rowgate[MOE_ROWS + pos1] = __uint_as_float(sv.z); }
    }
    if (w == 0) {
        for (int idx = F.tid; idx < 16 * 256; idx += NWAVES * 64) { const int q = idx >> 8, k = idx & 255, slot = q >> 3, padn = ((tot[q] + 255) & ~255) - tot[q];
            if (k < padn) { rowtok[slot * MOE_ROWS + gstart[q] + tot[q] + k] = -1; rowgate[slot * MOE_ROWS + gstart[q] + tot[q] + k] = 0.f; } }
        if (F.tid < 16) { const int slot = t >> 3, e = t & 7, t0 = gstart[t] >> 8, nt_ = (tot[t] + 255) >> 8;
            for (int k = 0; k < nt_; ++k) tiletab[16 + slot * MOE_TILES + t0 + k] = e;
            if (e == 7) tiletab[slot] = t0 + nt_; }
    }
    __syncthreads();
}
#ifndef MK_PER_PHASE
#define MK_PER_PHASE 0
#endif
constexpr int N_PHASES = 21;
static_assert(RING_OFF == 0 && pg8::STAGE_BYTES + 4096 + NWAVES * 1024 <= LDS_BYTES && MISC_OFF + 1024 <= RING_BYTES + 4096, "the gathered GEMM's per-wave row lists sit at [132K, 140K) of the LDS");
struct Args { const float* in[21]; float* out; unsigned char* ws; int ph_lo, ph_hi, use_bar, pad; };
#define RUN(p) (lo <= (p) && (p) < hi)
#define SEAM(p) do { if (lo <= (p) && (p) + 1 < hi) { int z_ = 0; asm volatile("" : "+v"(z_)); z_ = __builtin_amdgcn_readfirstlane(z_); XcdBarrier b2_ = bar; b2_.bar += z_; b2_.x += (unsigned)z_; xcd_barrier(b2_); } } while (0)
#define WSP(off) (arg_ws() + (off))
#define DO(p, ...) do { if (RUN(p)) { __VA_ARGS__ } } while (0)
template <int LAYER> __device__ __forceinline__ void layer_phases(const Frame& F, const XcdBarrier& bar, int lo, int hi) {
        constexpr int pb = LAYER * 9;
        DO(pb + 1, {
            pg8::Gemm g{(const bf16*)WSP(WS_H), (const bf16*)WSP(LAYER ? WS_WIN1 : WS_WIN0), D, 0, nullptr, D};
            pg8::StaticOrder S; S.init(T / 256, NINP / 256, F.G, (int)blockIdx.x, nullptr, 1, 0);
            pg8::EpiBf16 E{(bf16*)WSP(WS_BIG), NINP, LAYER ? (const unsigned long long*)((const unsigned*)WSP(WS_CTL) + CW_SSQ + 2 * T) : nullptr,
                           WIN_I8 ? 1.0f / ((LAYER ? HI8_SCALE : AI8_SCALE) * WI8_SCALE) : 1.0f, COL_RK, COL_RV, WIN_I8 ? 0.125f : 1.0f, COL_MQ, COL_MK, WIN_I8 ? 0.125f * LOG2E : 1.0f};
            pg8::gemm_phase<pg8::EpiBf16, pg8::StaticOrder, false, false, WIN_I8 ? 3 : 0>(F.lds + RING_OFF, g, S, E, F.wave);
            static_assert((T / 256) * (NINP / 256) == 6 * 256 + 128, "idle half round");
            if ((int)blockIdx.x >= 128) { Frame Fc = phase_frame(F); moe_conv_unit(Fc, WSP(0), LAYER * 128 + ((int)blockIdx.x - 128)); }
        });
        SEAM(pb + 1);
        DO(pb + 2, prep_phase(F, (const bf16*)WSP(WS_BIG), (float*)WSP(WS_BIG + BIG_STATE), (bf16*)WSP(WS_MISC + MS_KMEAN), (float*)WSP(WS_MISC + MS_KNORM)););
        SEAM(pb + 2);
        if (RUN(pb + 3)) scan_phase(F, (float*)WSP(WS_BIG + BIG_STATE));
        SEAM(pb + 3);
        DO(pb + 4, mixer_phase(F, (const bf16*)WSP(WS_BIG), (bf16*)WSP(WS_H), (const float*)WSP(WS_BIG + BIG_STATE), (const bf16*)WSP(WS_MISC + MS_KMEAN), (const float*)WSP(WS_MISC + MS_KNORM),
                                     (const bf16*)WSP(WS_MISC + MS_GW) + (size_t)LAYER * 65536, arg_in(LAYER ? 14 : 5), (unsigned*)WSP(WS_CTL) + CW_MIXQ + 64 * LAYER, LAYER ? WSP(0) : nullptr););
        SEAM(pb + 4);
        DO(pb + 5, {
            pg8::Gemm g{(const bf16*)WSP(WS_H), (const bf16*)WSP(LAYER ? WS_WOUT1 : WS_WOUT0), D, 0, nullptr, D};
            pg8::StaticOrder S; S.init(T / 256, D / 256, F.G, (int)blockIdx.x, nullptr, 1, 0);
            pg8::EpiResF32 E{LAYER ? (const void*)arg_out() : (const void*)arg_in(0), (bf16*)arg_out(), LAYER ? XLD : D, XLD, LAYER == 0};
            pg8::gemm_phase<pg8::EpiResF32, pg8::StaticOrder, false>(F.lds + RING_OFF, g, S, E, F.wave);
        });
        SEAM(pb + 5);
        if constexpr (LAYER == 0) {
            DO(6, if (DENSE_GU_FP8) norm8_phase(F, arg_out(), arg_in(6), WSP(WS_H), DENSE_GU_I8 != 0, true); else norm_phase(F, arg_out(), arg_in(6), (bf16*)WSP(WS_H)););
            SEAM(6);
            constexpr int GU0_MODE = !DENSE_GU_FP8 ? 0 : DENSE_GU_I8 ? 3 : 2;
            constexpr float GU0_SCALE = !DENSE_GU_FP8 ? 1.0f : DENSE_GU_I8 ? 1.0f / (AI8_SCALE * WI8_SCALE) : 1.0f / (A8_SCALE * W8_SCALE);
            constexpr int NF8 = DENSE_DN_FP8 == 1 ? T / 256 : DENSE_DN_FP8 == 2 ? T / 512 : 0;
            static_assert((size_t)NF8 * 256 * FF <= (size_t)NF8 * 256 * FF * 2 && (size_t)T * FF * 2 <= WS_END - WS_BIG, "hidden buffers");
            DO(7, {
                pg8::Gemm g{(const bf16*)WSP(WS_H), (const bf16*)WSP(WS_WGU0), D, 0, nullptr, D};
                if constexpr (NF8 > 0) {
                    pg8::StaticOrder S; S.init(NF8, 2 * FF / 256, F.G, (int)blockIdx.x, nullptr, 1, 0);
                    pg8::EpiSwiGLU8 E{WSP(WS_BIG), FF, GU0_SCALE, A8_SCALE};
                    pg8::gemm_phase<pg8::EpiSwiGLU8, pg8::StaticOrder, false, false, GU0_MODE>(F.lds + RING_OFF, g, S, E, F.wave); }
                if constexpr (NF8 < T / 256) {
                    pg8::StaticOrder S; S.init(T / 256 - NF8, 2 * FF / 256, F.G, (int)blockIdx.x, nullptr, 1, 0); S.gap_at = 0; S.gap = NF8;
                    pg8::EpiSwiGLU E{(bf16*)WSP(WS_BIG), FF, nullptr, GU0_SCALE};
                    pg8::gemm_phase<pg8::EpiSwiGLU, pg8::StaticOrder, false, false, GU0_MODE>(F.lds + RING_OFF, g, S, E, F.wave); }
            });
            SEAM(7);
            DO(8, {
                if constexpr (NF8 > 0) {
                    pg8::Gemm g{(const bf16*)WSP(WS_BIG), (const bf16*)WSP(WS_WDN0F8), FF, 0, nullptr, FF};
                    pg8::StaticOrder S; S.init(NF8, D / 256, F.G, (int)blockIdx.x, nullptr, 1, 0);
                    pg8::EpiResNorm E{(bf16*)arg_out(), XLD, arg_in(10), (void*)WSP(WS_H), D, (unsigned long long*)((unsigned*)WSP(WS_CTL) + CW_SSQ + 2 * T), 1.0f / (A8_SCALE * W8_SCALE), WIN_I8 ? HI8_SCALE : 0.f};
                    pg8::gemm_phase<pg8::EpiResNorm, pg8::StaticOrder, false, false, 2>(F.lds + RING_OFF, g, S, E, F.wave); }
                if constexpr (NF8 < T / 256) {
                    pg8::Gemm g{(const bf16*)WSP(WS_BIG), (const bf16*)WSP(WS_WDN0), FF, 0, nullptr, FF};
                    pg8::StaticOrder S; S.init(T / 256 - NF8, D / 256, F.G, (int)blockIdx.x, nullptr, 1, 0); S.gap_at = 0; S.gap = NF8;
                    pg8::EpiResNorm E{(bf16*)arg_out(), XLD, arg_in(10), (void*)WSP(WS_H), D, (unsigned long long*)((unsigned*)WSP(WS_CTL) + CW_SSQ + 2 * T), 1.0f, WIN_I8 ? HI8_SCALE : 0.f};
                    pg8::gemm_phase<pg8::EpiResNorm, pg8::StaticOrder, false, false, 0>(F.lds + RING_OFF, g, S, E, F.wave); }
            });
            SEAM(8);
        }
    }
#ifndef MOE_FP8
#define MOE_FP8 2
#endif
constexpr int MOE_KSPLIT = 7;
constexpr size_t WS_SLAB2 = WS_WIN0;
constexpr size_t WS_Y = WS_H;
static_assert(WS_SLAB2 + (size_t)64 * MOE_KSPLIT * 262144 <= WS_WDN1, "slab");
__device__ __forceinline__ void moe_order(pg8::StaticOrder& S, const int* tiletab, int nN, int G, int c, int split, int part) {
    const int t0 = tiletab[0], t1 = tiletab[1];
    S.init(t0 + t1, nN, G, c, tiletab + 16, split, part); S.gap_at = t0; S.gap = MOE_TILES - t0;
}
__device__ __forceinline__ void moe_combine(const Frame& F0) {
    Frame F = phase_frame(F0);
    const int* tiletab = (const int*)WSP(WS_MISC + MS_TILETAB);
    pg8::StaticOrder S; moe_order(S, tiletab, D / 256, F.G, 0, MOE_KSPLIT, 1);
    const int R = S.nwg - S.nfull;
    const float* slab = (const float*)WSP(WS_SLAB2); const int* rowtok = (const int*)WSP(WS_MISC + MS_ROWTOK); const float* rowgate = (const float*)WSP(WS_MISC + MS_ROWGATE);
    bf16* x = (bf16*)arg_out(); bf16* y = (bf16*)WSP(WS_Y);
    const int gw = F.vcu * NWAVES + F.wave, NGW = F.G * NWAVES;
    for (int idx = gw; idx < R * 256; idx += NGW) { const int r = idx >> 8, row = idx & 255; int pm, pn; S.decode(S.nfull + r, pm, pn);
        const int tok = rowtok[pm * 256 + row]; if (tok < 0) continue; const float gt = rowgate[pm * 256 + row] * (1.0f / (A8_SCALE * W8_SCALE));
        const float* sp = slab + (size_t)(r * MOE_KSPLIT) * 65536 + (size_t)row * 256 + 4 * F.lane;
        f32x4 s = *(const GAS f32x4*)sp;
#pragma unroll
        for (int q = 1; q < MOE_KSPLIT; ++q) s = s + *(const GAS f32x4*)(sp + (size_t)q * 65536);
        s = gt * s;
        if (pm < MOE_TILES) { GAS v2u* xp = (GAS v2u*)(x + (size_t)tok * XLD + pn * 256 + 4 * F.lane); const f32x4 r = bf4(*xp) + s; *xp = (v2u){pk2(r.x, r.y), pk2(r.z, r.w)}; }
        else *(GAS v2u*)(y + (size_t)tok * D + pn * 256 + 4 * F.lane) = (v2u){pk2(s.x, s.y), pk2(s.z, s.w)}; }
}
__device__ __forceinline__ void moe_phases(const Frame& F, const XcdBarrier& bar, int lo, int hi) {
        DO(17, {
            const int* tiletab = (const int*)WSP(WS_MISC + MS_TILETAB);
            pg8::Gemm g{(const bf16*)WSP(WS_H), (const bf16*)WSP(WS_WGU1), D, (size_t)2 * FF * D, (const int*)WSP(WS_MISC + MS_ROWTOK), D};
            pg8::StaticOrder S; moe_order(S, tiletab, 2 * FF / 256, F.G, (int)blockIdx.x, 1, 0);
            pg8::EpiSwiGLU8 E{WSP(WS_BIG), FF, MOE_GU_I8 ? 1.0f / (AI8_SCALE * WI8_SCALE) : 1.0f / (A8_SCALE * W8_SCALE), A8_SCALE};
            pg8::gemm_phase<pg8::EpiSwiGLU8, pg8::StaticOrder, true, false, MOE_GU_I8 ? 3 : MOE_FP8>(F.lds + RING_OFF, g, S, E, F.wave);
        });
        SEAM(17);
        DO(18, {
            const int* tiletab = (const int*)WSP(WS_MISC + MS_TILETAB);
            pg8::Gemm g{(const bf16*)WSP(WS_BIG), (const bf16*)WSP(WS_WDN1), FF, (size_t)D * FF, nullptr, FF};
            pg8::StaticOrder S; moe_order(S, tiletab, D / 256, F.G, (int)blockIdx.x, MOE_KSPLIT, 1);
            pg8::EpiScatter E{(bf16*)arg_out(), (bf16*)WSP(WS_Y), XLD, D, (const int*)WSP(WS_MISC + MS_ROWTOK), (const float*)WSP(WS_MISC + MS_ROWGATE), 1.0f / (A8_SCALE * W8_SCALE), (float*)WSP(WS_MISC + MS_DUMMY), MOE_TILES};
            pg8::gemm_phase<pg8::EpiScatter, pg8::StaticOrder, false, false, MOE_FP8>(F.lds + RING_OFF, g, S, E, F.wave);
            S.part = 2; g.klen = FF / MOE_KSPLIT;
            pg8::EpiSlab E2{(float*)WSP(WS_SLAB2)};
            pg8::gemm_phase<pg8::EpiSlab, pg8::StaticOrder, false, true, MOE_FP8>(F.lds + RING_OFF, g, S, E2, F.wave);
        });
        SEAM(18);
    }
__global__ void __launch_bounds__(NWAVES * 64, 2) fwd(Args args) {
    extern __shared__ __attribute__((aligned(16))) unsigned char lds_raw[];
    Frame F;
    F.lds = (LAS unsigned char*)lds_raw;
    volatile LAS unsigned* MISC = (volatile LAS unsigned*)(F.lds + MISC_OFF);
    F.tid = threadIdx.x; F.lane = F.tid & 63; F.wave = __builtin_amdgcn_readfirstlane(F.tid >> 6);
    F.G = gridDim.x; { const int bx = blockIdx.x; F.vcu = (F.G % 8 == 0) ? (bx % 8) * (F.G / 8) + bx / 8 : bx; }
    { unsigned char* ws0 = arg_ws();
      for (int u = F.tid; u < (LDS_BYTES - LDSCTL_OFF) / 4; u += NWAVES * 64) ((LAS unsigned*)(F.lds + LDSCTL_OFF))[u] = 0u;
      __syncthreads();
      (void)ws0; }
    XcdBarrier bar; bar.bar = (unsigned*)(arg_ws() + WS_CTL) + CW_BAR; bar.x = 0; bar.st = nullptr;
    if (args.use_bar) bar = xcd_barrier_post((unsigned*)(arg_ws() + WS_CTL) + CW_BAR, MISC + 8);
    const int lo = args.ph_lo, hi = args.ph_hi;

    DO(0, prologue_phase(F, WSP(0)); if (WIN_I8) norm8_phase(F, arg_in(0), arg_in(1), WSP(WS_H), true); else norm_phase(F, arg_in(0), arg_in(1), (bf16*)WSP(WS_H)););
    SEAM(0);
    layer_phases<0>(F, bar, lo, hi);
    layer_phases<1>(F, bar, lo, hi);
    DO(15, router_phase(F, (const bf16*)arg_out(), arg_in(15), arg_in(16), (bf16*)WSP(WS_H), (v4u*)WSP(WS_MISC + MS_SEL), (int*)WSP(WS_MISC + MS_COUNTS)););
    SEAM(15);
    DO(16, lists_phase(F, (const v4u*)WSP(WS_MISC + MS_SEL), (const int*)WSP(WS_MISC + MS_COUNTS), (int*)WSP(WS_MISC + MS_ROWTOK), (float*)WSP(WS_MISC + MS_ROWGATE), (int*)WSP(WS_MISC + MS_TILETAB)););
    SEAM(16);
    moe_phases(F, bar, lo, hi);
    if (RUN(19)) moe_combine(F);
    SEAM(19);
    if (RUN(20)) final_norm_phase(F, arg_out(), (const bf16*)WSP(WS_Y), arg_in(20));
#undef WSP
#undef RUN
#undef SEAM
}

extern "C" void kernel_launch(void* const* d_in, const int* in_sizes, int n_in, void* d_out, int out_size, void* d_ws, size_t ws_size, hipStream_t stream) {
    static int grid = 0;
    if (grid == 0) {
        if (n_in != 21 || in_sizes[0] != T * D || out_size != T * D || ws_size < WS_END) {
            fprintf(stderr, "kernel_launch: built for 21 inputs, x/out of %d floats, >= %zu bytes of workspace; got n_in %d, in0 %d, out %d, ws %zu; nothing launched\n", T * D, (size_t)WS_END, n_in, n_in > 0 ? in_sizes[0] : -1, out_size, ws_size);
            grid = -1; return; }
        int dev = 0, cus = 0, per_cu = 0;
        if (hipGetDevice(&dev) != hipSuccess || hipDeviceGetAttribute(&cus, hipDeviceAttributeMultiprocessorCount, dev) != hipSuccess) { fprintf(stderr, "kernel_launch: device query failed\n"); grid = -1; return; }
        if (hipFuncSetAttribute((const void*)fwd, hipFuncAttributeMaxDynamicSharedMemorySize, LDS_BYTES) != hipSuccess) { fprintf(stderr, "kernel_launch: hipFuncSetAttribute failed\n"); grid = -1; return; }
        if (hipOccupancyMaxActiveBlocksPerMultiprocessor(&per_cu, (const void*)fwd, NWAVES * 64, LDS_BYTES) != hipSuccess || per_cu < 1) { fprintf(stderr, "kernel_launch: occupancy query reports %d workgroups per CU\n", per_cu); }
        (void)hipGetLastError();
        if (cus != 256) { fprintf(stderr, "kernel_launch: built for 256 CUs, device has %d; nothing launched\n", cus); grid = -1; return; }
        grid = cus;
    }
    if (grid < 0) return;
    if (hipMemsetAsync((char*)d_ws + WS_CTL, 0, CTL_ZERO_BYTES, stream) != hipSuccess) { fprintf(stderr, "kernel_launch: hipMemsetAsync failed\n"); return; }
    Args a{};
    for (int i = 0; i < 21; ++i) a.in[i] = (const float*)d_in[i];
    a.out = (float*)d_out; a.ws = (unsigned char*)d_ws; a.pad = 0;
#if MK_PER_PHASE
    for (int p = 0; p < N_PHASES; ++p) { a.ph_lo = p; a.ph_hi = p + 1; a.use_bar = 0; hipLaunchKernelGGL(fwd, dim3(grid), dim3(NWAVES * 64), LDS_BYTES, stream, a); }
#else
    a.ph_lo = 0; a.ph_hi = N_PHASES; a.use_bar = 1;
    hipLaunchKernelGGL(fwd, dim3(grid), dim3(NWAVES * 64), LDS_BYTES, stream, a);
#endif
    const hipError_t le = hipPeekAtLastError();
    if (le != hipSuccess) fprintf(stderr, "kernel_launch: launch failed: %s\n", hipGetErrorName(le));
}
```

```cpp
#include <hip/hip_runtime.h>
#include <cstdio>
#include <cstdint>
namespace pg8 {
#define PG8_LAS __attribute__((address_space(3)))
typedef unsigned short bf16_t;
typedef short bf16x8 __attribute__((ext_vector_type(8)));
typedef float f32x4 __attribute__((ext_vector_type(4)));
typedef unsigned u32x4 __attribute__((ext_vector_type(4)));
typedef long i64x2 __attribute__((ext_vector_type(2)));
typedef int i32x4 __attribute__((ext_vector_type(4)));
typedef int i32x8 __attribute__((ext_vector_type(8)));
constexpr int BM = 256, BK = 64, HALF = 128, HTB = HALF * BK * 2  , STAGE_BYTES = 8 * HTB, NXCD = 8, WGM = 4;

__host__ __device__ __forceinline__ int lds_byte(int r, int c) { const int st = (r >> 4) * 2 + (c >> 5), rr = r & 15, cc = c & 31, ob = rr * 64 + cc * 2; return st * 1024 + (ob ^ (((ob >> 9) & 1) << 5)); }
__host__ __device__ __forceinline__ void stage_rc(int b, int& R, int& C) { const int st = b / 1024, sb = b % 1024, swz = sb ^ (((sb >> 9) & 1) << 5); R = (st >> 1) * 16 + swz / 64; C = (st & 1) * 32 + (swz % 64) / 2; }
__host__ __device__ __forceinline__ int perm32(int rho) { const int n = rho >> 4, i = rho & 15; return 8 * (i >> 2) + 4 * n + (i & 3); }

struct Unit { int pm, pn, e, kq, sub; };
struct Gemm { const bf16_t* A; const bf16_t* Bt; int K; size_t bstride; const int* rows; int klen; };

struct StaticOrder {
    int nM, nN, nwg, G, c; const int* tile_e;
    const PG8_LAS int* tile_l;
    int gap_at, gap;
    int nfull, split, part;
    __device__ __forceinline__ void init(int nM_, int nN_, int G_, int c_, const int* te, int split_, int part_) { nM = nM_; nN = nN_; nwg = nM * nN; G = G_; c = c_; tile_e = te; tile_l = nullptr;
        split = split_; part = part_; nfull = (split_ > 1) ? (nwg / G_) * G_ : nwg; gap_at = 0x7fffffff; gap = 0; }
    __device__ __forceinline__ void decode(int L, int& pm, int& pn) const {
        int wgid = L; { const int q = nwg / NXCD, r = nwg % NXCD, xcd = wgid % NXCD, off = wgid / NXCD; wgid = (xcd < r ? xcd * (q + 1) : r * (q + 1) + (xcd - r) * q) + off; }
        const int nig = WGM * nN, gid = wgid / nig, fm = gid * WGM, gsz = (nM - fm) < WGM ? (nM - fm) : WGM;
        pm = fm + ((wgid % nig) % gsz); pn = (wgid % nig) / gsz; if (pm >= gap_at) pm += gap; }
    __device__ __forceinline__ bool next(int i, Unit& u, int cofs) const {
        long L = (long)i * G + (c + cofs); u.kq = 0; u.sub = 0;
        if (part == 2) { if (L >= (long)(nwg - nfull) * split) return false; u.sub = (int)L; u.kq = (int)(L % split); L = nfull + L / split; }
        else if (L >= nfull) return false;
        decode((int)L, u.pm, u.pn); u.e = tile_l ? tile_l[u.pm] : tile_e ? tile_e[u.pm] : 0; return true;
    }
};

__device__ __forceinline__ unsigned cvt_pk_bf16(float lo, float hi) { unsigned r; asm volatile("v_cvt_pk_bf16_f32 %0, %1, %2" : "=v"(r) : "v"(lo), "v"(hi)); return r; }

__device__ __forceinline__ float row_rstd(const unsigned long long* ssq, int row) {
    if (!ssq) return 1.0f;
    const float s = (float)ssq[row] * (1.0f / 16777216.0f);
    return 1.0f / sqrtf(s * (1.0f / 1024.0f) + 1e-6f);
}
__device__ __forceinline__ unsigned pk4_i8(float a, float b, float c, float d) {
    a = __builtin_rintf(__builtin_amdgcn_fmed3f(a, -127.f, 127.f)) + 128.f; b = __builtin_rintf(__builtin_amdgcn_fmed3f(b, -127.f, 127.f)) + 128.f;
    c = __builtin_rintf(__builtin_amdgcn_fmed3f(c, -127.f, 127.f)) + 128.f; d = __builtin_rintf(__builtin_amdgcn_fmed3f(d, -127.f, 127.f)) + 128.f;
    unsigned w = 0; w = __builtin_amdgcn_cvt_pk_u8_f32(a, 0, w); w = __builtin_amdgcn_cvt_pk_u8_f32(b, 1, w); w = __builtin_amdgcn_cvt_pk_u8_f32(c, 2, w); w = __builtin_amdgcn_cvt_pk_u8_f32(d, 3, w);
    return w ^ 0x80808080u; }
struct EpiBf16 {
    static constexpr bool PERM = true;
    bf16_t* O; int ldc; const unsigned long long* ss;
    float scale; int ca0, ca1; float sa; int cb0, cb1; float sb;
    int q0, q1, q2, q3;
    __device__ __forceinline__ void operator()(const f32x4 (&acc)[2][2][4][2], const Unit& u, int wr, int wc, int fr, int fq) const {
        const int row0 = u.pm * BM + wr * 64 + fr, col0 = u.pn * BM + wc * 32 + 8 * fq;
        float rsv[2][4];
#pragma unroll
        for (int ai = 0; ai < 2; ++ai)
#pragma unroll
            for (int m = 0; m < 4; ++m) rsv[ai][m] = row_rstd(ss, row0 + ai * HALF + m * 16) * scale;
        float cs[2]; bool q8[2];
#pragma unroll
        for (int bj = 0; bj < 2; ++bj) { const int c = u.pn * BM + bj * HALF; cs[bj] = (c >= ca0 && c < ca1) ? sa : (c >= cb0 && c < cb1) ? sb : 1.0f; q8[bj] = (c >= q0 && c < q1) || (c >= q2 && c < q3); if (q8[bj]) cs[bj] = 32.0f; }
#pragma unroll
        for (int ai = 0; ai < 2; ++ai)
#pragma unroll
            for (int m = 0; m < 4; ++m) { const int row = row0 + ai * HALF + m * 16; bf16_t* rowp = O + (size_t)row * ldc + col0;
#pragma unroll
                for (int bj = 0; bj < 2; ++bj) { const float rs = rsv[ai][m] * cs[bj]; const f32x4 v0 = acc[ai][bj][m][0] * rs, v1 = acc[ai][bj][m][1] * rs;
                    if (q8[bj]) { typedef unsigned u32x2v __attribute__((ext_vector_type(2))); u32x2v w; w.x = pk4_i8(v0[0], v0[1], v0[2], v0[3]); w.y = pk4_i8(v1[0], v1[1], v1[2], v1[3]);
                        *(u32x2v*)((unsigned char*)(O + (size_t)row * ldc + u.pn * BM + bj * HALF) + wc * 32 + 8 * fq) = w; }
                    else { u32x4 w; w.x = cvt_pk_bf16(v0[0], v0[1]); w.y = cvt_pk_bf16(v0[2], v0[3]); w.z = cvt_pk_bf16(v1[0], v1[1]); w.w = cvt_pk_bf16(v1[2], v1[3]);
                        *(u32x4*)(rowp + bj * HALF) = w; } } }
    }
};
__device__ __forceinline__ float swiglu_f(float g, float u, float k, float c) { return (g * u) * __builtin_amdgcn_rcpf(fmaf(__builtin_amdgcn_exp2f(g * k), c, c)); }
struct EpiSwiGLU {
    static constexpr bool PERM = true;
    bf16_t* Hd; int ldc; const unsigned long long* ss; float scale;
    __device__ __forceinline__ void operator()(const f32x4 (&acc)[2][2][4][2], const Unit& u, int wr, int wc, int fr, int fq) const {
        const int row0 = u.pm * BM + wr * 64 + fr, col0 = u.pn * HALF + wc * 32 + 8 * fq;
        float rsv[2][4];
#pragma unroll
        for (int ai = 0; ai < 2; ++ai)
#pragma unroll
            for (int m = 0; m < 4; ++m) rsv[ai][m] = row_rstd(ss, row0 + ai * HALF + m * 16) * scale;
#pragma unroll
        for (int ai = 0; ai < 2; ++ai)
#pragma unroll
            for (int m = 0; m < 4; ++m) { const int row = row0 + ai * HALF + m * 16; bf16_t* rowp = Hd + (size_t)row * ldc + col0; const float rs = rsv[ai][m], k = -1.4426950408889634f * rs, c = __builtin_amdgcn_rcpf(rs * rs);
                const f32x4 g0 = acc[ai][0][m][0], g1 = acc[ai][0][m][1], u0 = acc[ai][1][m][0], u1 = acc[ai][1][m][1];
                float h[8];
#pragma unroll
                for (int j = 0; j < 4; ++j) { h[j] = swiglu_f(g0[j], u0[j], k, c); h[4 + j] = swiglu_f(g1[j], u1[j], k, c); }
                u32x4 w; w.x = cvt_pk_bf16(h[0], h[1]); w.y = cvt_pk_bf16(h[2], h[3]); w.z = cvt_pk_bf16(h[4], h[5]); w.w = cvt_pk_bf16(h[6], h[7]);
                *(u32x4*)rowp = w; }
    }
};
__device__ __forceinline__ unsigned pk4_e4m3(float a, float b, float c, float d) {
    a = __builtin_amdgcn_fmed3f(a, -448.f, 448.f); b = __builtin_amdgcn_fmed3f(b, -448.f, 448.f); c = __builtin_amdgcn_fmed3f(c, -448.f, 448.f); d = __builtin_amdgcn_fmed3f(d, -448.f, 448.f);
    unsigned w = 0; w = __builtin_amdgcn_cvt_pk_fp8_f32(a, b, w, false); w = __builtin_amdgcn_cvt_pk_fp8_f32(c, d, w, true); return w; }
struct EpiSwiGLU8 {
    static constexpr bool PERM = true;
    unsigned char* Hd; int ldc; float scale, oscale;
    __device__ __forceinline__ void operator()(const f32x4 (&acc)[2][2][4][2], const Unit& u, int wr, int wc, int fr, int fq) const {
        const int row0 = u.pm * BM + wr * 64 + fr, col0 = u.pn * HALF + wc * 32 + 8 * fq;
        const float k = -1.4426950408889634f * scale, c = 1.0f / (scale * scale * oscale);
#pragma unroll
        for (int ai = 0; ai < 2; ++ai)
#pragma unroll
            for (int m = 0; m < 4; ++m) { const int row = row0 + ai * HALF + m * 16; unsigned char* rowp = Hd + (size_t)row * ldc + col0;
                const f32x4 g0 = acc[ai][0][m][0], g1 = acc[ai][0][m][1], u0 = acc[ai][1][m][0], u1 = acc[ai][1][m][1];
                float h[8];
#pragma unroll
                for (int j = 0; j < 4; ++j) { h[j] = swiglu_f(g0[j], u0[j], k, c); h[4 + j] = swiglu_f(g1[j], u1[j], k, c); }
                typedef unsigned u32x2v __attribute__((ext_vector_type(2))); u32x2v w; w.x = pk4_e4m3(h[0], h[1], h[2], h[3]); w.y = pk4_e4m3(h[4], h[5], h[6], h[7]);
                *(u32x2v*)rowp = w; }
    }
};
__device__ __forceinline__ f32x4 ld4_bf16(const bf16_t* p) { typedef unsigned u32x2v __attribute__((ext_vector_type(2))); const u32x2v w = *(const u32x2v*)p;
    return (f32x4){__builtin_bit_cast(float, w.x << 16), __builtin_bit_cast(float, w.x & 0xffff0000u), __builtin_bit_cast(float, w.y << 16), __builtin_bit_cast(float, w.y & 0xffff0000u)}; }
__device__ __forceinline__ f32x4 st4_bf16(bf16_t* p, const f32x4 v) { typedef unsigned u32x2v __attribute__((ext_vector_type(2))); u32x2v w; w.x = cvt_pk_bf16(v[0], v[1]); w.y = cvt_pk_bf16(v[2], v[3]); *(u32x2v*)p = w;
    return (f32x4){__builtin_bit_cast(float, w.x << 16), __builtin_bit_cast(float, w.x & 0xffff0000u), __builtin_bit_cast(float, w.y << 16), __builtin_bit_cast(float, w.y & 0xffff0000u)}; }
struct EpiResF32 {
    static constexpr bool PERM = false;
    const void* base; bf16_t* out; int ldb, ldo; bool basef32;
    __device__ __forceinline__ void operator()(const f32x4 (&acc)[2][2][4][2], const Unit& u, int wr, int wc, int fr, int fq) const {
        const int row0 = u.pm * BM + wr * 64 + fr, col0 = u.pn * BM + wc * 32 + 4 * fq;
#pragma unroll
        for (int ai = 0; ai < 2; ++ai) { f32x4 bs[4][2][2];
#pragma unroll
            for (int m = 0; m < 4; ++m) { const size_t off = (size_t)(row0 + ai * HALF + m * 16) * ldb + col0;
#pragma unroll
                for (int bj = 0; bj < 2; ++bj)
#pragma unroll
                    for (int n = 0; n < 2; ++n) bs[m][bj][n] = basef32 ? *(const f32x4*)((const float*)base + off + bj * HALF + n * 16) : ld4_bf16((const bf16_t*)base + off + bj * HALF + n * 16); }
#pragma unroll
            for (int m = 0; m < 4; ++m) { const size_t off = (size_t)(row0 + ai * HALF + m * 16) * ldo + col0;
#pragma unroll
                for (int bj = 0; bj < 2; ++bj)
#pragma unroll
                    for (int n = 0; n < 2; ++n) st4_bf16(out + off + bj * HALF + n * 16, bs[m][bj][n] + acc[ai][bj][m][n]); } }
    }
};
struct EpiResNorm {
    static constexpr bool PERM = false;
    bf16_t* x; int ldc; const float* gain; void* Hn; int ldh; unsigned long long* ss; float ascale; float h8scale;
    __device__ __forceinline__ void operator()(const f32x4 (&acc)[2][2][4][2], const Unit& u, int wr, int wc, int fr, int fq) const {
        const int row0 = u.pm * BM + wr * 64 + fr, col0 = u.pn * BM + wc * 32 + 4 * fq;
        f32x4 gv[2][2];
#pragma unroll
        for (int bj = 0; bj < 2; ++bj)
#pragma unroll
            for (int n = 0; n < 2; ++n) gv[bj][n] = *(const f32x4*)(gain + col0 + bj * HALF + n * 16);
#pragma unroll
        for (int ai = 0; ai < 2; ++ai) { f32x4 bs[4][2][2];
#pragma unroll
            for (int m = 0; m < 4; ++m) { const size_t off = (size_t)(row0 + ai * HALF + m * 16) * ldc + col0;
#pragma unroll
                for (int bj = 0; bj < 2; ++bj)
#pragma unroll
                    for (int n = 0; n < 2; ++n) bs[m][bj][n] = ld4_bf16(x + off + bj * HALF + n * 16); }
#pragma unroll
            for (int m = 0; m < 4; ++m) { const int row = row0 + ai * HALF + m * 16; const size_t off = (size_t)row * ldc + col0, offh = (size_t)row * ldh + col0; float sq = 0.f;
#pragma unroll
                for (int bj = 0; bj < 2; ++bj)
#pragma unroll
                    for (int n = 0; n < 2; ++n) { const f32x4 v = st4_bf16(x + off + bj * HALF + n * 16, bs[m][bj][n] + acc[ai][bj][m][n] * ascale);
                        sq += (v[0] * v[0] + v[1] * v[1]) + (v[2] * v[2] + v[3] * v[3]); const f32x4 hv = v * gv[bj][n];
                        if (h8scale > 0.f) *(unsigned*)((unsigned char*)Hn + offh + bj * HALF + n * 16) = pk4_i8(hv[0] * h8scale, hv[1] * h8scale, hv[2] * h8scale, hv[3] * h8scale);
                        else { typedef unsigned u32x2v __attribute__((ext_vector_type(2))); u32x2v w; w.x = cvt_pk_bf16(hv[0], hv[1]); w.y = cvt_pk_bf16(hv[2], hv[3]); *(u32x2v*)((bf16_t*)Hn + offh + bj * HALF + n * 16) = w; } }
                sq += __shfl_xor(sq, 16); sq += __shfl_xor(sq, 32);
                if (fq == 0) atomicAdd(ss + row, (unsigned long long)(sq * 16777216.0f + 0.5f)); } }
    }
};
struct EpiScatter {
    static constexpr bool PERM = false;
    bf16_t* X; bf16_t* Y; int ldx, ldy; const int* rowtok; const float* rowgate; float scale; float* dummy; int ysplit;
    __device__ __forceinline__ void operator()(const f32x4 (&acc)[2][2][4][2], const Unit& u, int wr, int wc, int fr, int fq) const {
        const int row0 = u.pm * BM + wr * 64 + fr, col0 = u.pn * BM + wc * 32 + 4 * fq;
        int tok[2][4]; float gt[2][4];
#pragma unroll
        for (int ai = 0; ai < 2; ++ai)
#pragma unroll
            for (int m = 0; m < 4; ++m) { const int r = row0 + ai * HALF + m * 16; tok[ai][m] = rowtok[r]; gt[ai][m] = rowgate[r] * scale; }
        if (u.pm < ysplit) {
#pragma unroll
        for (int ai = 0; ai < 2; ++ai) { f32x4 bs[4][2][2]; bf16_t* xp[4];
#pragma unroll
            for (int m = 0; m < 4; ++m) xp[m] = (tok[ai][m] >= 0 ? X + (size_t)tok[ai][m] * ldx : (bf16_t*)dummy) + col0;
#pragma unroll
            for (int m = 0; m < 4; ++m)
#pragma unroll
                for (int bj = 0; bj < 2; ++bj)
#pragma unroll
                    for (int n = 0; n < 2; ++n) bs[m][bj][n] = ld4_bf16(xp[m] + bj * HALF + n * 16);
#pragma unroll
            for (int m = 0; m < 4; ++m)
#pragma unroll
                for (int bj = 0; bj < 2; ++bj)
#pragma unroll
                    for (int n = 0; n < 2; ++n) st4_bf16(xp[m] + bj * HALF + n * 16, bs[m][bj][n] + gt[ai][m] * acc[ai][bj][m][n]); }
        } else {
#pragma unroll
        for (int ai = 0; ai < 2; ++ai)
#pragma unroll
            for (int m = 0; m < 4; ++m) { bf16_t* yp = (tok[ai][m] >= 0 ? Y + (size_t)tok[ai][m] * ldy : (bf16_t*)dummy) + col0;
#pragma unroll
                for (int bj = 0; bj < 2; ++bj)
#pragma unroll
                    for (int n = 0; n < 2; ++n) st4_bf16(yp + bj * HALF + n * 16, gt[ai][m] * acc[ai][bj][m][n]); }
        }
    }
};

struct EpiSlab {
    static constexpr bool PERM = false;
    float* slab;
    __device__ __forceinline__ void operator()(const f32x4 (&acc)[2][2][4][2], const Unit& u, int wr, int wc, int fr, int fq) const {
        float* sp = slab + (size_t)u.sub * 65536 + (size_t)(wr * 64 + fr) * 256 + wc * 32 + 4 * fq;
#pragma unroll
        for (int ai = 0; ai < 2; ++ai)
#pragma unroll
            for (int m = 0; m < 4; ++m)
#pragma unroll
                for (int bj = 0; bj < 2; ++bj)
#pragma unroll
                    for (int n = 0; n < 2; ++n) *(f32x4*)(sp + (size_t)(ai * HALF + m * 16) * 256 + bj * HALF + n * 16) = acc[ai][bj][m][n];
    }
};

#ifndef PG8_SP2
#define PG8_SP2 true
#endif
template <class Epi, class Sched, bool GATHER, bool KSPLIT = false, int FP8 = 0, bool SP2 = PG8_SP2>
__device__ __forceinline__ void gemm_phase(PG8_LAS unsigned char* lds, const Gemm g, const Sched& S, const Epi& E, int wave_id) {
    int lane; asm volatile("v_mbcnt_lo_u32_b32 %0, -1, 0\n\tv_mbcnt_hi_u32_b32 %0, -1, %0" : "=v"(lane));
    int z_ = 0; asm volatile("" : "+v"(z_)); z_ = __builtin_amdgcn_readfirstlane(z_);
    const int wid = wave_id + z_, tid = wid * 64 + lane, wr = wid >> 2, wc = wid & 3, fr = lane & 15, fq = lane >> 4;
    constexpr int ESZ = FP8 != 0 ? 1 : 2;
    const int K = g.K * ESZ / 2, nt = g.klen * ESZ / (BK * 2);
    unsigned voffA[2], voffB[2]; int gR[2], gC2[2];
#pragma unroll
    for (int i = 0; i < 2; ++i) { int R, C; stage_rc(tid * 16 + i * 8192, R, C); const int Rb = Epi::PERM ? ((R & ~31) + perm32(R & 31)) : R;
        voffA[i] = (unsigned)(R * K + C) * 2u; voffB[i] = (unsigned)(Rb * K + C) * 2u; gR[i] = R; gC2[i] = C * 2; }
    const size_t kstep = (size_t)(BK * 2);
    const size_t hstep = (size_t)HALF * K * 2;
    const size_t tstep = 2 * hstep;
    const unsigned ldsw = (unsigned)wid * 1024u;
    const int aoff = lds_byte(wr * 64 + fr, fq * 8), boff = lds_byte(wc * 32 + fr, fq * 8);
    unsigned cv[2][2] = {{0u, 0u}, {0u, 0u}}, nv[2][2] = {{0u, 0u}, {0u, 0u}};
#define PG8_SA(b, h) (((b) * 2 + (h)) * HTB)
#define PG8_SB(b, h) ((4 + (b) * 2 + (h)) * HTB)
#define PG8_STAGEX(bufoff, gbase, voff, aux) do { _Pragma("unroll") for (int _i = 0; _i < 2; ++_i) \
        __builtin_amdgcn_global_load_lds((const unsigned*)((const char*)(gbase) + (voff)[_i]), (PG8_LAS unsigned*)(lds + (bufoff) + ldsw + _i * 8192), 16, 0, aux); } while (0)
#define PG8_STAGE(bufoff, gbase, voff) PG8_STAGEX(bufoff, gbase, voff, 0)
#define PG8_STAGE_A(b, h, kptr, usen) do { if constexpr (GATHER) { _Pragma("unroll") for (int _i = 0; _i < 2; ++_i) { const unsigned _vo = (usen) ? nv[h][_i] : cv[h][_i]; \
        __builtin_amdgcn_global_load_lds((const unsigned*)((const char*)(kptr) + _vo), (PG8_LAS unsigned*)(lds + PG8_SA(b, h) + ldsw + _i * 8192), 16, 0, 0); } } \
        else { PG8_STAGEX(PG8_SA(b, h), (kptr) + (h) * hstep, voffA, 0); } } while (0)
#define PG8_ROWS(dst, unit) do { _Pragma("unroll") for (int _h = 0; _h < 2; ++_h) _Pragma("unroll") for (int _i = 0; _i < 2; ++_i) { int _t = g.rows[(unit).pm * BM + _h * HALF + gR[_i]]; _t = _t < 0 ? 0 : _t; \
        dst[_h][_i] = (unsigned)_t * (unsigned)(K * 2) + (unsigned)gC2[_i]; } } while (0)
#define PG8_ROWL_OFF (STAGE_BYTES + 4096)
#define PG8_ROWS_LDS(dst) do { _Pragma("unroll") for (int _h = 0; _h < 2; ++_h) _Pragma("unroll") for (int _i = 0; _i < 2; ++_i) { int _t = *(const PG8_LAS int*)(lds + PG8_ROWL_OFF + wid * 1024 + (_h * HALF + gR[_i]) * 4); _t = _t < 0 ? 0 : _t; \
        dst[_h][_i] = (unsigned)_t * (unsigned)(K * 2) + (unsigned)gC2[_i]; } } while (0)
#define PG8_LDA(dst, b, h) do { _Pragma("unroll") for (int m = 0; m < 4; ++m) { if constexpr (FP8 == 2) { const i32x4 _l = *(const PG8_LAS i32x4*)(lds + PG8_SA(b, h) + aoff + m * 2048), _h = *(const PG8_LAS i32x4*)(lds + PG8_SA(b, h) + aoff + m * 2048 + 1024); \
        dst##8[m] = __builtin_shufflevector(_l, _h, 0, 1, 2, 3, 4, 5, 6, 7); } else { _Pragma("unroll") for (int k = 0; k < 2; ++k) dst[m][k] = *(const PG8_LAS bf16x8*)(lds + PG8_SA(b, h) + aoff + m * 2048 + k * 1024); } } } while (0)
#define PG8_LDB(dst, b, h) do { _Pragma("unroll") for (int n = 0; n < 2; ++n) { if constexpr (FP8 == 2) { const i32x4 _l = *(const PG8_LAS i32x4*)(lds + PG8_SB(b, h) + boff + n * 2048), _h = *(const PG8_LAS i32x4*)(lds + PG8_SB(b, h) + boff + n * 2048 + 1024); \
        dst##8[n] = __builtin_shufflevector(_l, _h, 0, 1, 2, 3, 4, 5, 6, 7); } else { _Pragma("unroll") for (int k = 0; k < 2; ++k) dst[n][k] = *(const PG8_LAS bf16x8*)(lds + PG8_SB(b, h) + boff + n * 2048 + k * 1024); } } } while (0)
#define PG8_MMA(ai, bj, At, Bt) do { __builtin_amdgcn_s_setprio(1); \
        if constexpr (FP8 == 3) { _Pragma("unroll") for (int k = 0; k < 2; ++k) _Pragma("unroll") for (int m = 0; m < 4; ++m) _Pragma("unroll") for (int n = 0; n < 2; ++n) \
            asm volatile("s_nop 1\n\tv_mfma_i32_16x16x64_i8 %0, %1, %2, %0" : "+v"(acc[ai][bj][m][n]) : "v"(Bt[n][k]), "v"(At[m][k])); } \
        _Pragma("unroll") for (int m = 0; m < 4; ++m) _Pragma("unroll") for (int n = 0; n < 2; ++n) { \
        if constexpr (FP8 == 2) { asm volatile("s_nop 1\n\tv_mfma_scale_f32_16x16x128_f8f6f4 %0, %1, %2, %0, %3, %3 op_sel_hi:[0,0,0]" : "+v"(acc[ai][bj][m][n]) : "v"(Bt##8[n]), "v"(At##8[m]), "v"(mxscale)); } \
        else _Pragma("unroll") for (int k = 0; k < 2; ++k) { \
        if constexpr (FP8 == 3) { } \
        else if constexpr (FP8 == 1) { const i64x2 a8 = __builtin_bit_cast(i64x2, At[m][k]), b8 = __builtin_bit_cast(i64x2, Bt[n][k]); \
            acc[ai][bj][m][n] = __builtin_amdgcn_mfma_f32_16x16x32_fp8_fp8(b8[0], a8[0], acc[ai][bj][m][n], 0, 0, 0); acc[ai][bj][m][n] = __builtin_amdgcn_mfma_f32_16x16x32_fp8_fp8(b8[1], a8[1], acc[ai][bj][m][n], 0, 0, 0); } \
        else acc[ai][bj][m][n] = __builtin_amdgcn_mfma_f32_16x16x32_bf16(Bt[n][k], At[m][k], acc[ai][bj][m][n], 0, 0, 0); } } __builtin_amdgcn_s_setprio(0); } while (0)
#define PG8_MMAQ(ai, bj, At, Bt) PG8_MMA(ai, bj, At, Bt)
#define PG8_WAIT_V(n) asm volatile("s_waitcnt vmcnt(" #n ")" ::: "memory")
#define PG8_WAIT_L(n) asm volatile("s_waitcnt lgkmcnt(" #n ")" ::: "memory")
#define PG8_BAR __builtin_amdgcn_s_barrier()
#define PG8_SCHED __builtin_amdgcn_sched_barrier(0)
    Unit cur, nxt; int ui = 0;
    if (!S.next(0, cur, z_)) return;
    f32x4 acc[2][2][4][2];
#pragma unroll
    for (int a = 0; a < 2; ++a)
#pragma unroll
        for (int b = 0; b < 2; ++b)
#pragma unroll
            for (int m = 0; m < 4; ++m)
#pragma unroll
                for (int n = 0; n < 2; ++n) acc[a][b][m][n] = (f32x4){0.f, 0.f, 0.f, 0.f};
    bf16x8 At[4][2], B0[2][2], B1[2][2];
    i32x8 At8[4], B08[2], B18[2];
    const int mxscale = 0x7f7f7f7f;
    const size_t kqb = KSPLIT ? (size_t)g.klen * ESZ : 0;
    const char* cA = GATHER ? (const char*)g.A : (const char*)g.A + (size_t)cur.pm * tstep + cur.kq * kqb;
    const char* cB = (const char*)g.Bt + ((size_t)cur.e * g.bstride) * ESZ + (size_t)cur.pn * tstep + cur.kq * kqb;
    if constexpr (GATHER) { PG8_ROWS(cv, cur); }
    if constexpr (SP2) {
    PG8_STAGE(PG8_SB(0, 0), cB, voffB); PG8_STAGE(PG8_SB(0, 1), cB + hstep, voffB); PG8_STAGE_A(0, 0, cA, false); PG8_STAGE_A(0, 1, cA, false);
    if (wr == 1) PG8_BAR;
    PG8_WAIT_V(2); PG8_BAR;
    PG8_STAGE(PG8_SB(1, 0), cB + kstep, voffB); PG8_STAGE_A(1, 0, cA + kstep, false); PG8_STAGE(PG8_SB(1, 1), cB + hstep + kstep, voffB);
    PG8_WAIT_V(6); PG8_BAR;
    } else {
    PG8_STAGE(PG8_SB(0, 0), cB, voffB); PG8_STAGE_A(0, 0, cA, false); PG8_STAGE(PG8_SB(0, 1), cB + hstep, voffB); PG8_STAGE_A(0, 1, cA, false);
    if (wr == 1) PG8_BAR;
    PG8_WAIT_V(4); PG8_BAR;
    PG8_STAGE(PG8_SB(1, 0), cB + kstep, voffB); PG8_STAGE_A(1, 0, cA + kstep, false); PG8_STAGE(PG8_SB(1, 1), cB + hstep + kstep, voffB);
    PG8_WAIT_V(6); PG8_BAR;
    }
    for (;;) {
        const bool has_next = S.next(ui + 1, nxt, z_);
        const char* nA = (has_next && !GATHER) ? (const char*)g.A + (size_t)nxt.pm * tstep + nxt.kq * kqb : cA;
        const char* nB = has_next ? (const char*)g.Bt + ((size_t)nxt.e * g.bstride) * ESZ + (size_t)nxt.pn * tstep + nxt.kq * kqb : cB;
        if constexpr (GATHER) { if (has_next) __builtin_amdgcn_global_load_lds((const unsigned*)(g.rows + (size_t)nxt.pm * BM + 4 * lane), (PG8_LAS unsigned*)(lds + PG8_ROWL_OFF + wid * 1024), 16, 0, 0); }
        for (int t = 0; t < nt; t += 2) {
            const bool last = (t == nt - 2);
            const bool un = last && has_next;
            const char* a1 = cA + (size_t)(t + 1) * kstep;
            const char* a2 = last ? nA : cA + (size_t)(t + 2) * kstep; const char* b2 = last ? nB : cB + (size_t)(t + 2) * kstep;
            const char* a3 = a2 + kstep; const char* b3 = b2 + kstep;
            if constexpr (GATHER) { if (un) { PG8_ROWS_LDS(nv); } }
            if constexpr (SP2) {
            PG8_LDB(B0, 0, 0); PG8_LDB(B1, 0, 1); PG8_SCHED; PG8_LDA(At, 0, 0); PG8_STAGE_A(1, 1, a1, false);
            PG8_WAIT_V(8); PG8_WAIT_L(0); PG8_BAR; PG8_MMAQ(0, 0, At, B0); PG8_MMAQ(0, 1, At, B1); PG8_BAR; PG8_SCHED;
            PG8_LDA(At, 0, 1); PG8_STAGE(PG8_SB(0, 0), b2, voffB); PG8_STAGE(PG8_SB(0, 1), b2 + hstep, voffB); PG8_STAGE_A(0, 0, a2, un);
            PG8_WAIT_V(8); PG8_WAIT_L(0); PG8_BAR; PG8_MMAQ(1, 0, At, B0); PG8_MMAQ(1, 1, At, B1); PG8_BAR; PG8_SCHED;
            PG8_LDB(B0, 1, 0); PG8_LDB(B1, 1, 1); PG8_SCHED; PG8_LDA(At, 1, 0); PG8_STAGE_A(0, 1, a2, un);
            PG8_WAIT_V(8); PG8_WAIT_L(0); PG8_BAR; PG8_MMAQ(0, 0, At, B0); PG8_MMAQ(0, 1, At, B1); PG8_BAR; PG8_SCHED;
            PG8_LDA(At, 1, 1); PG8_STAGE(PG8_SB(1, 0), b3, voffB); PG8_STAGE(PG8_SB(1, 1), b3 + hstep, voffB); PG8_STAGE_A(1, 0, a3, un);
            PG8_WAIT_V(8); PG8_WAIT_L(0); PG8_BAR; PG8_MMAQ(1, 0, At, B0); PG8_MMAQ(1, 1, At, B1); PG8_BAR; PG8_SCHED;
            } else {
            PG8_LDB(B0, 0, 0); PG8_SCHED; PG8_LDA(At, 0, 0); PG8_STAGE_A(1, 1, a1, false);
            PG8_WAIT_L(8); PG8_BAR; PG8_WAIT_L(0); PG8_MMAQ(0, 0, At, B0); PG8_BAR; PG8_SCHED;
            PG8_LDB(B1, 0, 1); PG8_STAGE(PG8_SB(0, 0), b2, voffB);
            PG8_BAR; PG8_WAIT_L(0); PG8_MMAQ(0, 1, At, B1); PG8_BAR;
            PG8_LDA(At, 0, 1); PG8_STAGE_A(0, 0, a2, un);
            PG8_BAR; PG8_WAIT_L(0); PG8_MMAQ(1, 0, At, B0); PG8_BAR; PG8_SCHED;
            PG8_STAGE(PG8_SB(0, 1), b2 + hstep, voffB);
            PG8_WAIT_V(6); PG8_BAR; PG8_MMAQ(1, 1, At, B1); PG8_BAR;
            PG8_LDB(B0, 1, 0); PG8_SCHED; PG8_LDA(At, 1, 0); PG8_STAGE_A(0, 1, a2, un);
            PG8_WAIT_L(8); PG8_BAR; PG8_WAIT_L(0); PG8_MMAQ(0, 0, At, B0); PG8_BAR; PG8_SCHED;
            PG8_LDB(B1, 1, 1); PG8_STAGE(PG8_SB(1, 0), b3, voffB);
            PG8_BAR; PG8_WAIT_L(0); PG8_MMAQ(0, 1, At, B1); PG8_BAR;
            PG8_LDA(At, 1, 1); PG8_STAGE_A(1, 0, a3, un);
            PG8_BAR; PG8_WAIT_L(0); PG8_MMAQ(1, 0, At, B0); PG8_BAR; PG8_SCHED;
            PG8_STAGE(PG8_SB(1, 1), b3 + hstep, voffB);
            PG8_WAIT_V(6); PG8_BAR; PG8_MMAQ(1, 1, At, B1); PG8_BAR;
            }
        }
        if constexpr (FP8 == 2) asm volatile("s_nop 15\n\ts_nop 15" ::: "memory");
        if constexpr (FP8 == 3) asm volatile("s_nop 15\n\ts_nop 15\n\ts_nop 15\n\ts_nop 15\n\ts_nop 15\n\ts_nop 15" ::: "memory");
        if constexpr (FP8 == 3) {
#pragma unroll
            for (int a = 0; a < 2; ++a)
#pragma unroll
                for (int b = 0; b < 2; ++b)
#pragma unroll
                    for (int m = 0; m < 4; ++m)
#pragma unroll
                        for (int n = 0; n < 2; ++n)
                            { const i32x4 t_ = __builtin_bit_cast(i32x4, acc[a][b][m][n]); acc[a][b][m][n] = __builtin_convertvector(t_, f32x4); } }
        if (wr == 0) PG8_BAR;
        E(acc, cur, wr, wc, fr, fq);
        if (!has_next) break;
#pragma unroll
        for (int a = 0; a < 2; ++a)
#pragma unroll
            for (int b = 0; b < 2; ++b)
#pragma unroll
                for (int m = 0; m < 4; ++m)
#pragma unroll
                    for (int n = 0; n < 2; ++n) acc[a][b][m][n] = (f32x4){0.f, 0.f, 0.f, 0.f};
        cur = nxt; cA = nA; cB = nB; ++ui;
        if constexpr (GATHER) {
#pragma unroll
            for (int h = 0; h < 2; ++h) { cv[h][0] = nv[h][0]; cv[h][1] = nv[h][1]; } }
        if (wr == 1) PG8_BAR;
    }
    PG8_WAIT_V(0);
    PG8_BAR;
#undef PG8_SA
#undef PG8_SB
#undef PG8_STAGE
#undef PG8_STAGEX
#undef PG8_STAGE_A
#undef PG8_ROWS
#undef PG8_ROWS_LDS
#undef PG8_ROWL_OFF
#undef PG8_LDA
#undef PG8_LDB
#undef PG8_MMA
#undef PG8_MMAQ
#undef PG8_WAIT_V
#undef PG8_WAIT_L
#undef PG8_BAR
#undef PG8_SCHED
}
}
constexpr int BATCH = 8, SEQ = 4096, T = BATCH * SEQ, D = 1024, NIN = 3200, NINP = 3328, FF = 3584, NE = 8, NH = 6;
constexpr int COL_RQ = 0, COL_RK = 384, COL_RV = 768, COL_RG = 1152, COL_MQ = 1536, COL_MK = 1920, COL_MV = 2304, COL_GU = 2688, COL_GV = 2944;
constexpr int MOE_TILES = 136, MOE_ROWS = MOE_TILES * 256;
constexpr float LOG2E = 1.4426950408889634f;
#ifndef DENSE_GU_I8
#define DENSE_GU_I8 1
#endif
constexpr float AI8_SCALE = 32.0f, WI8_SCALE = 1024.0f;
constexpr int XLD = 2 * D;
#ifndef PROJ_I8
#define PROJ_I8 1
#endif
#ifndef MOE_GU_I8
#define MOE_GU_I8 1
#endif
#ifndef WIN_I8
#define WIN_I8 1
#endif
constexpr float HI8_SCALE = 16.0f;
#ifndef DENSE_DN_FP8
#define DENSE_DN_FP8 1
#endif
#ifndef DENSE_GU_FP8
#define DENSE_GU_FP8 1
#endif
constexpr float W8_SCALE = 32.0f, A8_SCALE = 8.0f;
constexpr int NWAVES = 8;

constexpr size_t MiB = 1u << 20;
constexpr size_t WS_CTL = 0, CTL_ZERO_BYTES = 1 * MiB;
constexpr size_t WS_MISC = 1 * MiB;
constexpr size_t WS_WIN0 = 5 * MiB, WIN_BYTES = (size_t)NINP * D * 2, WS_WIN1 = WS_WIN0 + WIN_BYTES;
constexpr size_t WS_WDN0F8 = 99 * MiB;
constexpr size_t WS_SLAB = 103 * MiB;
constexpr size_t WS_WOUT0 = 18 * MiB, WS_WOUT1 = 20 * MiB;
constexpr size_t WS_WGU0 = 22 * MiB, WS_WDN0 = 36 * MiB;
constexpr size_t WS_WGU1 = 43 * MiB, WS_WDN1 = 155 * MiB;
constexpr size_t WS_STATEB = 184 * MiB;
constexpr size_t WS_H = 211 * MiB;
constexpr size_t WS_BIG = 275 * MiB;
constexpr size_t BIG_STATE = (size_t)T * NINP * 2;
constexpr size_t WS_END = 513 * MiB;
static_assert(WS_WIN1 + WIN_BYTES <= WS_WOUT0 && WS_WGU0 + (size_t)2 * FF * D * 2 <= WS_WDN0 && WS_WDN0 + (size_t)D * FF * 2 <= WS_WGU1, "ws map 1");
static_assert(WS_WGU1 + (size_t)NE * 2 * FF * D * 2 <= WS_WDN1 && WS_WDN1 + (size_t)NE * D * FF * 2 <= WS_H && WS_H + (size_t)T * D * 2 <= WS_BIG, "ws map 2");
static_assert(WS_WDN1 + (size_t)NE * D * FF <= WS_STATEB && WS_STATEB + (size_t)BATCH * NH * 32 * 4096 * 2 <= WS_H, "ws map 2b");
static_assert(BIG_STATE + (size_t)BATCH * NH * 32 * 4096 * 4 <= WS_END - WS_BIG && (size_t)MOE_ROWS * FF * 2 <= WS_END - WS_BIG, "ws map 3");
constexpr size_t MS_KMEAN = 0;
constexpr size_t MS_KNORM = 100 * 1024;
constexpr size_t MS_GW = 128 * 1024;
constexpr size_t MS_SEL = 512 * 1024;
constexpr size_t MS_ROWTOK = 1024 * 1024;
constexpr size_t MS_ROWGATE = 1344 * 1024;
constexpr size_t MS_COUNTS = 1664 * 1024;
constexpr size_t MS_TOKPOS = 2304 * 1024;
constexpr size_t MS_DUMMY = 2048 * 1024;
constexpr size_t MS_TILETAB = 1680 * 1024;
static_assert(MS_ROWTOK + 2 * MOE_ROWS * 4 <= MS_ROWGATE && MS_ROWGATE + 2 * MOE_ROWS * 4 <= MS_COUNTS, "misc map");
constexpr int CW_BAR = 4096;
constexpr int CW_MIXQ = 8192;
constexpr int CW_SSQ = 131072;

constexpr int RING_OFF = 0, RING_BYTES = 131072;
constexpr int LDSCTL_OFF = RING_BYTES, MISC_OFF = LDSCTL_OFF + 320;
constexpr int LDS_BYTES = 147456;

#define GAS __attribute__((address_space(1)))
#define LAS __attribute__((address_space(3)))
typedef unsigned short bf16;
typedef unsigned v4u __attribute__((ext_vector_type(4)));
typedef unsigned v2u __attribute__((ext_vector_type(2)));
typedef float f32x4 __attribute__((ext_vector_type(4)));
typedef float f32x16 __attribute__((ext_vector_type(16)));
typedef short bf16x8 __attribute__((ext_vector_type(8)));
typedef short s16x4 __attribute__((ext_vector_type(4)));
typedef GAS unsigned gu32;
#define RLX_AGENT __ATOMIC_RELAXED, __HIP_MEMORY_SCOPE_AGENT
#define LDS_WAIT() asm volatile("s_waitcnt lgkmcnt(0)" ::: "memory")
__device__ __forceinline__ unsigned f2bf(float f) { unsigned u = __builtin_bit_cast(unsigned, f); return (u + 0x7fffu + ((u >> 16) & 1u)) >> 16; }
__device__ __forceinline__ unsigned pk2(float lo, float hi) { return f2bf(lo) | (f2bf(hi) << 16); }
typedef float f32x2_t __attribute__((ext_vector_type(2))); typedef __bf16 bf16x2_t __attribute__((ext_vector_type(2)));
__device__ __forceinline__ unsigned cvtpk(float lo, float hi) { f32x2_t v = {lo, hi}; bf16x2_t b = __builtin_convertvector(v, bf16x2_t); return __builtin_bit_cast(unsigned, b); }
__device__ __forceinline__ unsigned pk4_fp8(float a, float b, float c, float d) {
    a = __builtin_amdgcn_fmed3f(a, -448.f, 448.f); b = __builtin_amdgcn_fmed3f(b, -448.f, 448.f); c = __builtin_amdgcn_fmed3f(c, -448.f, 448.f); d = __builtin_amdgcn_fmed3f(d, -448.f, 448.f);
    unsigned w = 0; w = __builtin_amdgcn_cvt_pk_fp8_f32(a, b, w, false); w = __builtin_amdgcn_cvt_pk_fp8_f32(c, d, w, true); return w; }
__device__ __forceinline__ float bflo(unsigned w) { return __uint_as_float(w << 16); }
__device__ __forceinline__ float bfhi(unsigned w) { return __uint_as_float(w & 0xffff0000u); }
__device__ __forceinline__ f32x4 bf4(v2u w) { return (f32x4){bflo(w.x), bfhi(w.x), bflo(w.y), bfhi(w.y)}; }
__device__ __forceinline__ f32x4 proj4(const bf16* pr, int c) {
    if (PROJ_I8) { const unsigned w = *(const GAS unsigned*)((const unsigned char*)pr + c + (c & ~127));
        return (f32x4){(float)(int)(signed char)(w & 255u), (float)(int)(signed char)((w >> 8) & 255u), (float)(int)(signed char)((w >> 16) & 255u), (float)(int)(signed char)(w >> 24)} * (1.0f / 32.0f); }
    const v2u w = *(const GAS v2u*)(pr + c); return (f32x4){bflo(w.x), bfhi(w.x), bflo(w.y), bfhi(w.y)};
}
__device__ __forceinline__ v4u i8x8_bf(v2u w, float s) {
    const unsigned a = w.x ^ 0x80808080u, b = w.y ^ 0x80808080u; const float o = -128.0f * s; v4u r;
    r.x = pk2(fmaf((float)(a & 255u), s, o), fmaf((float)((a >> 8) & 255u), s, o)); r.y = pk2(fmaf((float)((a >> 16) & 255u), s, o), fmaf((float)(a >> 24), s, o));
    r.z = pk2(fmaf((float)(b & 255u), s, o), fmaf((float)((b >> 8) & 255u), s, o)); r.w = pk2(fmaf((float)((b >> 16) & 255u), s, o), fmaf((float)(b >> 24), s, o));
    return r; }
__device__ __forceinline__ v2u proj8_raw(const bf16* pr, int c) { return *(const GAS v2u*)((const unsigned char*)pr + c + (c & ~127)); }
__device__ __forceinline__ float readlane_f(float v, int l) { return __int_as_float(__builtin_amdgcn_readlane(__float_as_int(v), l)); }
__device__ __forceinline__ float ex2(float x) { return __builtin_amdgcn_exp2f(x); }
__device__ __forceinline__ f32x16 mfma32(bf16x8 a, bf16x8 b, f32x16 c) { return __builtin_amdgcn_mfma_f32_32x32x16_bf16(a, b, c, 0, 0, 0); }
__device__ __forceinline__ int crow16(int r) { return (r & 3) + 8 * (r >> 2); }
__device__ __forceinline__ s16x4 trd(const LAS unsigned char* p) { return __builtin_bit_cast(s16x4, __builtin_amdgcn_ds_read_tr16_b64_v4i16((LAS s16x4*)p)); }
__device__ __forceinline__ bf16x8 cat8(s16x4 a, s16x4 b) { return (bf16x8){a[0], a[1], a[2], a[3], b[0], b[1], b[2], b[3]}; }
__device__ __forceinline__ bf16x8 packstep(const f32x16& x, int s) {
    v4u w; w.x = cvtpk(x[8 * s], x[8 * s + 1]); w.y = cvtpk(x[8 * s + 2], x[8 * s + 3]); w.z = cvtpk(x[8 * s + 4], x[8 * s + 5]); w.w = cvtpk(x[8 * s + 6], x[8 * s + 7]);
    return __builtin_bit_cast(bf16x8, w);
}
__device__ __forceinline__ float wave_sum(float v) {
#pragma unroll
    for (int o = 1; o < 64; o <<= 1) v += __shfl_xor(v, o);
    return v;
}
__device__ __forceinline__ float gelu_tanh(float x) {
    const float y = 1.5957691216057308f * (x + 0.044715f * x * x * x);
    return x * __builtin_amdgcn_rcpf(1.0f + ex2(-LOG2E * y));
}
__device__ __forceinline__ float silu(float x) { return x * __builtin_amdgcn_rcpf(1.0f + ex2(-LOG2E * x)); }

#define XB_TMO      128
#define XB_XCNT(j)  (256  + 64 * (j))
#define XB_XSUB(j)  (1280 + 64 * (j))
#define XB_XGEN(j)  (2304 + 64 * (j))
#define XB_TOP      3328
#define XB_TOPGEN   3392
#define XCD_BAR_WORDS 3456
#define XB_SPIN_CAP (1u << 18)

__device__ __forceinline__ unsigned xb_ld(unsigned* p)              { return __hip_atomic_load(p, __ATOMIC_RELAXED, __HIP_MEMORY_SCOPE_AGENT); }
__device__ __forceinline__ unsigned xb_add(unsigned* p, unsigned v) { return __hip_atomic_fetch_add(p, v, __ATOMIC_RELAXED, __HIP_MEMORY_SCOPE_AGENT); }
__device__ __forceinline__ unsigned xb_xcc_id() { return (unsigned)__builtin_amdgcn_s_getreg((3 << 11) | 20) & 0xFu; }
#define XB_SPIN(cond, bar) do { unsigned _sp = 0; while (cond) { __builtin_amdgcn_s_sleep(1); \
    if ((++_sp & 255u) == 0u) { if (xb_ld(&(bar)[XB_TMO])) break; if (_sp > XB_SPIN_CAP) { atomicAdd(&(bar)[XB_TMO], 1u); break; } } } } while (0)

struct XcdBarrier {
    unsigned* bar; unsigned x;
    volatile LAS unsigned* st;
};
__device__ __forceinline__ XcdBarrier xcd_barrier_post(unsigned* bar, volatile LAS unsigned* st) {
    XcdBarrier b; b.bar = bar; b.x = xb_xcc_id(); b.st = st;
    if (threadIdx.x == 0) (void)xb_add(&bar[XB_XCNT(b.x)], 1u);
    return b;
}
__device__ __forceinline__ void xcd_barrier_complete(unsigned* bar, unsigned x, unsigned& nloc, unsigned& nx) {
    const unsigned G = gridDim.x * gridDim.y * gridDim.z;
    unsigned sum, cnt, mine, sp = 0u;
    for (;;) {
        sum = 0u; cnt = 0u; mine = 0u;
#pragma unroll
        for (unsigned j = 0; j < 16; ++j) { const unsigned c = xb_ld(&bar[XB_XCNT(j)]); sum += c; cnt += (c > 0u) ? 1u : 0u; mine = (j == x) ? c : mine; }
        if (sum == G) break;
        __builtin_amdgcn_s_sleep(1);
        if ((++sp & 255u) == 0u) { if (xb_ld(&bar[XB_TMO])) break; if (sp > XB_SPIN_CAP) { atomicAdd(&bar[XB_TMO], 1u); break; } }
    }
    nloc = mine > 0u ? mine : 1u; nx = cnt > 0u ? cnt : 1u;
}
__device__ __forceinline__ void xcd_barrier(const XcdBarrier& b) {
    asm volatile("s_waitcnt vmcnt(0)" ::: "memory");
    __syncthreads();
    if (threadIdx.x == 0) {
        unsigned* bar = b.bar;
        __builtin_amdgcn_s_waitcnt(0);
        unsigned nloc = b.st[0], nx = b.st[1];
        if (nloc == 0u) { xcd_barrier_complete(bar, b.x, nloc, nx); b.st[0] = nloc; b.st[1] = nx; }
        const unsigned old = xb_add(&bar[XB_XSUB(b.x)], 1u);
        const unsigned gen = old / nloc;
        if (old + 1u == (gen + 1u) * nloc) {
            __builtin_amdgcn_fence(__ATOMIC_RELEASE, "agent");
            asm volatile("s_waitcnt vmcnt(0)" ::: "memory");
            const unsigned og = xb_add(&bar[XB_TOP], 1u);
            const unsigned tg = og / nx;
            if (og + 1u == (tg + 1u) * nx) xb_add(&bar[XB_TOPGEN], 1u);
            else XB_SPIN(xb_ld(&bar[XB_TOPGEN]) == tg, bar);
            __builtin_amdgcn_fence(__ATOMIC_ACQUIRE, "agent");
            xb_add(&bar[XB_XGEN(b.x)], 1u);
            asm volatile("s_waitcnt vmcnt(0)" ::: "memory");
        } else {
            XB_SPIN(xb_ld(&bar[XB_XGEN(b.x)]) == gen, bar);
            __builtin_amdgcn_fence(__ATOMIC_ACQUIRE, "agent");
            asm volatile("s_waitcnt vmcnt(0)" ::: "memory");
        }
    }
    __syncthreads();
}

struct Frame {
    LAS unsigned char* lds;
    int tid, lane, wave;
    int vcu, G;
};
__device__ __forceinline__ int lane_id_opaque() { int l; asm volatile("v_mbcnt_lo_u32_b32 %0, -1, 0\n\tv_mbcnt_hi_u32_b32 %0, -1, %0" : "=v"(l)); return l; }
__device__ __forceinline__ int zero_opaque() { int z = 0; asm volatile("" : "+v"(z)); return __builtin_amdgcn_readfirstlane(z); }
__device__ __forceinline__ Frame phase_frame(const Frame& F0) { Frame F = F0; const int z = zero_opaque(); F.lane = lane_id_opaque(); F.wave = F0.wave + z; F.tid = F.wave * 64 + F.lane; F.vcu = F0.vcu + z; F.G = F0.G + z; return F; }

__device__ __forceinline__ void transpose_item(const float* W, int K, int N, bf16* WT, int kb, int n0, int drow0, float scale, LAS float* scr, int lane) {
    const int k0 = 64 * kb;
    float v[32];
    { const float* wp = W + (size_t)(k0 + (lane >> 5)) * N + n0 + (lane & 31);
#pragma unroll
      for (int i = 0; i < 32; ++i) v[i] = __builtin_nontemporal_load(wp + (size_t)(2 * i) * N); }
#pragma unroll
    for (int i = 0; i < 32; ++i) { const int kk = 2 * i + (lane >> 5); scr[kk * 33 + (lane & 31)] = v[i]; }
    LDS_WAIT(); asm volatile("" ::: "memory");
    const int c = lane & 7;
#pragma unroll
    for (int j = 0; j < 4; ++j) { const int n = (lane >> 3) + 8 * j; const LAS float* s = scr + (8 * c) * 33 + n;
        v4u o; o.x = pk2(s[0 * 33] * scale, s[1 * 33] * scale); o.y = pk2(s[2 * 33] * scale, s[3 * 33] * scale); o.z = pk2(s[4 * 33] * scale, s[5 * 33] * scale); o.w = pk2(s[6 * 33] * scale, s[7 * 33] * scale);
        *(GAS v4u*)(WT + (size_t)(drow0 + n) * K + k0 + 8 * c) = o; }
    LDS_WAIT(); asm volatile("" ::: "memory");
}
__device__ __forceinline__ void transpose_item8(const float* W, int K, int N, unsigned char* WT, int kb, int n0, int drow0, float scale, LAS float* scr, int lane, bool i8 = false) {
    const int k0 = 64 * kb;
    float v[32];
    { const float* wp = W + (size_t)(k0 + (lane >> 5)) * N + n0 + (lane & 31);
#pragma unroll
      for (int i = 0; i < 32; ++i) v[i] = __builtin_nontemporal_load(wp + (size_t)(2 * i) * N); }
#pragma unroll
    for (int i = 0; i < 32; ++i) { const int kk = 2 * i + (lane >> 5); scr[kk * 33 + (lane & 31)] = v[i]; }
    LDS_WAIT(); asm volatile("" ::: "memory");
    const int c = lane & 7;
#pragma unroll
    for (int j = 0; j < 4; ++j) { const int n = (lane >> 3) + 8 * j; const LAS float* sp = scr + (8 * c) * 33 + n;
        v2u o;
        if (i8) { o.x = pg8::pk4_i8(sp[0 * 33] * scale, sp[1 * 33] * scale, sp[2 * 33] * scale, sp[3 * 33] * scale); o.y = pg8::pk4_i8(sp[4 * 33] * scale, sp[5 * 33] * scale, sp[6 * 33] * scale, sp[7 * 33] * scale); }
        else { o.x = pk4_fp8(sp[0 * 33] * scale, sp[1 * 33] * scale, sp[2 * 33] * scale, sp[3 * 33] * scale); o.y = pk4_fp8(sp[4 * 33] * scale, sp[5 * 33] * scale, sp[6 * 33] * scale, sp[7 * 33] * scale); }
        *(GAS v2u*)(WT + (size_t)(drow0 + n) * K + k0 + 8 * c) = o; }
    LDS_WAIT(); asm volatile("" ::: "memory");
}
__device__ __forceinline__ void rms_row_to_bf16(const float* xrow, const f32x4 (&gn)[4], bf16* orow, int lane) {
    const GAS f32x4* xr = (const GAS f32x4*)xrow + lane;
    f32x4 v[4]; float s = 0.f;
#pragma unroll
    for (int j = 0; j < 4; ++j) { v[j] = xr[64 * j]; s += (v[j].x * v[j].x + v[j].y * v[j].y) + (v[j].z * v[j].z + v[j].w * v[j].w); }
    const float rstd = 1.f / sqrtf(wave_sum(s) * (1.f / D) + 1e-6f);
    GAS unsigned long long* o8 = (GAS unsigned long long*)orow + lane;
#pragma unroll
    for (int j = 0; j < 4; ++j) { const f32x4 y = v[j] * rstd * gn[j]; o8[64 * j] = (unsigned long long)pk2(y.x, y.y) | ((unsigned long long)pk2(y.z, y.w) << 32); }
}
__device__ __forceinline__ void norm_phase(const Frame& F0, const float* x, const float* gain, bf16* H) {
    Frame F = phase_frame(F0);
    f32x4 gn[4];
#pragma unroll
    for (int j = 0; j < 4; ++j) gn[j] = *((const GAS f32x4*)gain + F.lane + 64 * j);
    const int gw = F.vcu * NWAVES + F.wave, NGW = F.G * NWAVES;
    for (int m = gw; m < T; m += NGW) rms_row_to_bf16(x + (size_t)m * D, gn, H + (size_t)m * D, F.lane);
}
__device__ __forceinline__ void norm8_phase(const Frame& F0, const void* x, const float* gain, unsigned char* H8, bool i8 = false, bool xbf = false) {
    Frame F = phase_frame(F0);
    f32x4 gn[4];
#pragma unroll
    for (int j = 0; j < 4; ++j) gn[j] = *((const GAS f32x4*)gain + F.lane + 64 * j);
    const int gw = F.vcu * NWAVES + F.wave, NGW = F.G * NWAVES;
    for (int m = gw; m < T; m += NGW) {
        f32x4 v[4]; float s = 0.f;
        if (xbf) { const GAS v2u* xr = (const GAS v2u*)((const bf16*)x + (size_t)m * XLD) + F.lane;
#pragma unroll
            for (int j = 0; j < 4; ++j) v[j] = bf4(xr[64 * j]); }
        else { const GAS f32x4* xr = (const GAS f32x4*)((const float*)x + (size_t)m * D) + F.lane;
#pragma unroll
            for (int j = 0; j < 4; ++j) v[j] = xr[64 * j]; }
#pragma unroll
        for (int j = 0; j < 4; ++j) s += (v[j].x * v[j].x + v[j].y * v[j].y) + (v[j].z * v[j].z + v[j].w * v[j].w);
        const float rstd = (i8 ? AI8_SCALE : A8_SCALE) / sqrtf(wave_sum(s) * (1.f / D) + 1e-6f);
        GAS unsigned* o8 = (GAS unsigned*)(H8 + (size_t)m * D) + F.lane;
#pragma unroll
        for (int j = 0; j < 4; ++j) { const f32x4 y = v[j] * rstd * gn[j]; o8[64 * j] = i8 ? pg8::pk4_i8(y.x, y.y, y.z, y.w) : pk4_fp8(y.x, y.y, y.z, y.w); } }
}
__device__ __forceinline__ void final_norm_phase(const Frame& F0, float* xo, const bf16* y, const float* gain) {
    Frame F = phase_frame(F0);
    f32x4 gn[4];
#pragma unroll
    for (int j = 0; j < 4; ++j) gn[j] = *((const GAS f32x4*)gain + F.lane + 64 * j);
    const int gw = F.vcu * NWAVES + F.wave, NGW = F.G * NWAVES;
    for (int m = gw; m < T; m += NGW) {
        GAS f32x4* xr = (GAS f32x4*)(xo + (size_t)m * D) + F.lane;
        const GAS v2u* xb = (const GAS v2u*)((const bf16*)xo + (size_t)m * XLD) + F.lane;
        const GAS v2u* yr = (const GAS v2u*)(y + (size_t)m * D) + F.lane;
        f32x4 v[4]; v2u xv[4], yv[4]; float s = 0.f;
#pragma unroll
        for (int j = 0; j < 4; ++j) { xv[j] = xb[64 * j]; yv[j] = yr[64 * j]; }
#pragma unroll
        for (int j = 0; j < 4; ++j) { v[j] = bf4(xv[j]) + bf4(yv[j]);
            s += (v[j].x * v[j].x + v[j].y * v[j].y) + (v[j].z * v[j].z + v[j].w * v[j].w); }
        const float rstd = 1.f / sqrtf(wave_sum(s) * (1.f / D) + 1e-6f);
#pragma unroll
        for (int j = 0; j < 4; ++j) xr[64 * j] = v[j] * rstd * gn[j];
    }
}
#define CAS __attribute__((address_space(4)))
__device__ __forceinline__ const float* arg_in(int k) { const CAS char* ka = (const CAS char*)__builtin_amdgcn_kernarg_segment_ptr(); return *(const float* const volatile CAS*)(ka + 8 * k); }
__device__ __forceinline__ float* arg_out() { const CAS char* ka = (const CAS char*)__builtin_amdgcn_kernarg_segment_ptr(); return *(float* const volatile CAS*)(ka + 8 * 21); }
__device__ __forceinline__ unsigned char* arg_ws() { const CAS char* ka = (const CAS char*)__builtin_amdgcn_kernarg_segment_ptr(); return *(unsigned char* const volatile CAS*)(ka + 8 * 22); }
__device__ __forceinline__ void ffn_item(unsigned char* ws, int mi, int r, LAS float* scr, int lane) {
    const int e = mi < 3 ? 0 : (mi - 3) / 3, kind = mi < 3 ? mi : (mi - 3) % 3;
    if (kind < 2) { const int kb = r / (FF / 32), n0 = 32 * (r % (FF / 32));
        const float* src = mi < 3 ? arg_in(kind ? 8 : 7) : arg_in(kind ? 18 : 17) + (size_t)e * D * FF;
        if (mi < 3) { if (DENSE_GU_FP8) transpose_item8(src, D, FF, ws + WS_WGU0, kb, n0, 256 * (n0 >> 7) + (n0 & 127) + 128 * kind, DENSE_GU_I8 ? WI8_SCALE : W8_SCALE, scr, lane, DENSE_GU_I8 != 0);
                      else transpose_item(src, D, FF, (bf16*)(ws + WS_WGU0), kb, n0, 256 * (n0 >> 7) + (n0 & 127) + 128 * kind, 1.0f, scr, lane); }
        else transpose_item8(src, D, FF, ws + WS_WGU1 + (size_t)e * 2 * FF * D, kb, n0, 256 * (n0 >> 7) + (n0 & 127) + 128 * kind, MOE_GU_I8 ? WI8_SCALE : W8_SCALE, scr, lane, MOE_GU_I8 != 0);
    } else { const int kb = r / (D / 32), n0 = 32 * (r % (D / 32));
        const float* src = mi < 3 ? arg_in(9) : arg_in(19) + (size_t)e * FF * D;
        if (mi < 3) { if (DENSE_DN_FP8 != 1) transpose_item(src, FF, D, (bf16*)(ws + WS_WDN0), kb, n0, n0, 1.0f, scr, lane);
                      if (DENSE_DN_FP8 != 0) transpose_item8(src, FF, D, ws + WS_WDN0F8, kb, n0, n0, W8_SCALE, scr, lane); }
        else transpose_item8(src, FF, D, ws + WS_WDN1 + (size_t)e * D * FF, kb, n0, n0, W8_SCALE, scr, lane); }
}
__device__ __forceinline__ void moe_conv_unit(Frame& F, unsigned char* ws, int cu, int mi0 = 3) {
    LAS float* scr = (LAS float*)(F.lds + RING_OFF + F.wave * 16384);
#pragma unroll 1
    for (int k = 0; k < 3; ++k) { const int it = cu * 24 + F.wave * 3 + k; ffn_item(ws, mi0 + it / 1792, it % 1792, scr, F.lane); }
}
__device__ __forceinline__ void prologue_phase(const Frame& F0, unsigned char* ws) {
    Frame F = phase_frame(F0);
    LAS float* scr = (LAS float*)(F.lds + RING_OFF + F.wave * 16384);
    const int gw = F.vcu * NWAVES + F.wave, NGW = F.G * NWAVES;
    constexpr int I_IN = (D / 64) * (NIN / 32), I_OUT = (D / 64) * (D / 32), I_FF = (D / 64) * (FF / 32);
    static_assert((FF / 64) * (D / 32) == I_FF, "down items");
    constexpr int B_OUT = 2 * I_IN, B_FF = B_OUT + 2 * I_OUT, NITEMS = B_FF;
    for (int it = gw; it < NITEMS; it += NGW) {
        if (it < B_OUT) { const int l = it / I_IN, r = it % I_IN, kb = r / (NIN / 32), n0 = 32 * (r % (NIN / 32));
            const float sc = (n0 >= COL_RK && n0 < COL_RV) ? 0.125f : (n0 >= COL_MQ && n0 < COL_MK) ? 0.125f * LOG2E : 1.0f;
            if (WIN_I8) transpose_item8(arg_in(l ? 11 : 2), D, NIN, ws + (l ? WS_WIN1 : WS_WIN0), kb, n0, n0, WI8_SCALE, scr, F.lane, true);
            else transpose_item(arg_in(l ? 11 : 2), D, NIN, (bf16*)(ws + (l ? WS_WIN1 : WS_WIN0)), kb, n0, n0, sc, scr, F.lane);
            continue; }
        if (it < B_FF) { const int l = (it - B_OUT) / I_OUT, r = (it - B_OUT) % I_OUT, kb = r / (D / 32), n0 = 32 * (r % (D / 32));
            transpose_item(arg_in(l ? 12 : 3), D, D, (bf16*)(ws + (l ? WS_WOUT1 : WS_WOUT0)), kb, n0, n0, 1.0f, scr, F.lane); continue; }
    }
    const int gt = F.vcu * (NWAVES * 64) + F.tid, NGT = F.G * NWAVES * 64;
    for (int i = gt; i < 2 * 16384; i += NGT) { const int l = i >> 14, p = i & 16383; if (WIN_I8 && p >= 8192) continue; *(GAS v4u*)(ws + (l ? WS_WIN1 : WS_WIN0) + (size_t)NIN * D * (WIN_I8 ? 1 : 2) + (size_t)p * 16) = (v4u){0u, 0u, 0u, 0u}; }
    for (int i = gt; i < 2 * 65536; i += NGT) { const int l = i >> 16, p = i & 65535, row = (p >> 7) & 127, col = p & 127;
        const float w = arg_in(l ? 13 : 4)[p]; ((bf16*)(ws + WS_MISC + MS_GW))[i] = (bf16)(col <= row ? f2bf(w) : 0u); }
}

__device__ __forceinline__ void qk_tile(f32x16& p0, f32x16& p1, const LAS unsigned char* kimg, const bf16x8 (&qf)[4], int r32, int hi) {
    const LAS unsigned char* kb = kimg + hi * 1024 + r32 * 16;
    p0 = (f32x16){0.f, 0.f, 0.f, 0.f, 0.f, 0.f, 0.f, 0.f, 0.f, 0.f, 0.f, 0.f, 0.f, 0.f, 0.f, 0.f}; p1 = p0;
#pragma unroll
    for (int d0 = 0; d0 < 4; ++d0) {
        const bf16x8 a0 = *(const LAS bf16x8*)(kb + d0 * 2048), a1 = *(const LAS bf16x8*)(kb + d0 * 2048 + 512);
        p0 = mfma32(a0, qf[d0], p0); p1 = mfma32(a1, qf[d0], p1); }
}
__device__ __forceinline__ void qk_tile_c(f32x16& p0, f32x16& p1, const f32x16& c0, const f32x16& c1, const LAS unsigned char* kimg, const bf16x8 (&qf)[4], int r32, int hi) {
    const LAS unsigned char* kb = kimg + hi * 1024 + r32 * 16;
    bf16x8 a[8];
#pragma unroll
    for (int d0 = 0; d0 < 4; ++d0) { a[2 * d0] = *(const LAS bf16x8*)(kb + d0 * 2048); a[2 * d0 + 1] = *(const LAS bf16x8*)(kb + d0 * 2048 + 512); }
#pragma unroll
    for (int d0 = 0; d0 < 4; ++d0) { p0 = mfma32(a[2 * d0], qf[d0], d0 ? p0 : c0); p1 = mfma32(a[2 * d0 + 1], qf[d0], d0 ? p1 : c1); }
}
__device__ __forceinline__ void pv_tile(f32x16& o0, f32x16& o1, const LAS unsigned char* vimg, const f32x16& p0, const f32x16& p1, int hi, int q4, int p4, int blk) {
    const LAS unsigned char* vb = vimg + (4 * hi + q4) * 64 + blk * 32 + p4 * 8;
    bf16x8 v0[4], v1[4];
#pragma unroll
    for (int k = 0; k < 4; ++k) { const int ro = (32 * (k >> 1) + 16 * (k & 1)) * 64;
        v0[k] = cat8(trd(vb + ro), trd(vb + ro + 512)); v1[k] = cat8(trd(vb + 4096 + ro), trd(vb + 4096 + ro + 512)); }
#pragma unroll
    for (int k = 0; k < 4; ++k) { const bf16x8 pf = packstep((k >> 1) ? p1 : p0, k & 1);
        o0 = mfma32(v0[k], pf, o0); o1 = mfma32(v1[k], pf, o1); }
}
__device__ __forceinline__ void store_ot(bf16* orow, const f32x16& o0, const f32x16& o1, int hi) {
#pragma unroll
    for (int c2 = 0; c2 < 2; ++c2)
#pragma unroll
        for (int g = 0; g < 4; ++g) { const f32x16& o = c2 ? o1 : o0;
            *(GAS v2u*)(orow + 32 * c2 + 8 * g + 4 * hi) = (v2u){cvtpk(o[4 * g], o[4 * g + 1]), cvtpk(o[4 * g + 2], o[4 * g + 3])}; }
}

#define MB_INIT(P0, P1, KVB) do { const float ct_ = lanesel ? fmaf(slope2, (float)(KVB), cl) - mref : -1e30f; \
    _Pragma("unroll") for (int r = 0; r < 16; ++r) { P0[r] = fmaf(slope2, (float)crow16(r), ct_); P1[r] = fmaf(slope2, (float)(crow16(r) + 32), ct_); } } while (0)
#define MB_SOFTMAX(P0, P1, HASNX, NX0, NX1) do { \
    float mx = fmaxf(fmaxf(P0[0], P0[1]), P1[0]), mx2 = fmaxf(fmaxf(P0[2], P0[3]), P1[1]); mx = fmaxf(fmaxf(mx, P1[2]), P1[3]); \
    _Pragma("unroll") for (int r = 4; r < 16; r += 4) { mx = fmaxf(fmaxf(mx, P0[r]), P0[r + 1]); mx2 = fmaxf(fmaxf(mx2, P0[r + 2]), P0[r + 3]); mx = fmaxf(fmaxf(mx, P1[r]), P1[r + 1]); mx2 = fmaxf(fmaxf(mx2, P1[r + 2]), P1[r + 3]); } \
    mx = fmaxf(mx, mx2); \
    { auto rr = __builtin_amdgcn_permlane32_swap(__float_as_uint(mx), __float_as_uint(mx), false, false); mx = fmaxf(__uint_as_float(rr[0]), __uint_as_float(rr[1])); } \
    if (__builtin_amdgcn_ballot_w64(mx > THR) != 0ull) { const float dl = fmaxf(mx, 0.f); mref += dl; const float f = ex2(-dl); l *= f; \
        _Pragma("unroll") for (int r = 0; r < 16; ++r) { P0[r] -= dl; P1[r] -= dl; o0[r] *= f; o1[r] *= f; if (HASNX) { NX0[r] -= dl; NX1[r] -= dl; } } } \
    float rs = 0.f, rs2 = 0.f; \
    _Pragma("unroll") for (int r = 0; r < 16; ++r) { P0[r] = ex2(P0[r]); P1[r] = ex2(P1[r]); rs += P0[r]; rs2 += P1[r]; } \
    l += rs + rs2; } while (0)
__device__ __forceinline__ void moba_unit(Frame& F, const bf16* proj, bf16* mix, const bf16* kmean, const float* knorm, int b, int h, int ob) {
    const int tid = F.tid, lane = F.lane, wid = F.wave, r32 = lane & 31, hi = lane >> 5, q4 = (lane & 15) >> 2, p4 = lane & 3, blk = (lane >> 4) & 1;
    LAS unsigned char* lds = F.lds + RING_OFF;
    LAS float* wq = (LAS float*)(F.lds + LDSCTL_OFF + 64);
    const int tq = ob * 256 + wid * 32 + r32;
    const bf16* qp = proj + (size_t)(b * SEQ + tq) * NINP;
    bf16x8 qf[4];
#pragma unroll
    for (int d0 = 0; d0 < 4; ++d0) qf[d0] = __builtin_bit_cast(bf16x8, i8x8_bf(proj8_raw(qp, COL_MQ + h * 64 + hi * 8 + d0 * 16), 0.125f * LOG2E / 32.0f));
    const float knv = knorm[(size_t)(b * NH + h) * 64 + lane];
    float qn;
    { float qs = 0.f;
#pragma unroll
      for (int d0 = 0; d0 < 4; ++d0)
#pragma unroll
        for (int j = 0; j < 8; ++j) { const float v = __uint_as_float(((unsigned)(unsigned short)qf[d0][j]) << 16); qs += v * v; }
      qs += __shfl_xor(qs, 32); qn = sqrtf(qs) * 1.0001f;
      float wm = qn;
#pragma unroll
      for (int o = 1; o < 32; o <<= 1) wm = fmaxf(wm, __shfl_xor(wm, o));
      if (lane == 0) wq[wid] = wm; }
    unsigned selmask = 0u;
    if (ob > 0) {
        const int kb_ = (r32 & 3) + 4 * (r32 >> 3);
        const bf16* kmp = kmean + ((size_t)((b * NH + h) * 16 + kb_)) * 64 + hi * 8;
        f32x16 sc = (f32x16){0.f, 0.f, 0.f, 0.f, 0.f, 0.f, 0.f, 0.f, 0.f, 0.f, 0.f, 0.f, 0.f, 0.f, 0.f, 0.f};
#pragma unroll
        for (int d0 = 0; d0 < 4; ++d0) sc = mfma32(*(const bf16x8*)(kmp + d0 * 16), qf[d0], sc);
#pragma unroll
        for (int pass = 0; pass < 3; ++pass) { float best = -__builtin_inff(); int bi = -1;
#pragma unroll
            for (int r = 0; r < 16; ++r) { const bool ok = (r < ob) && !((selmask >> r) & 1u) && (sc[r] > best); best = ok ? sc[r] : best; bi = ok ? r : bi; }
            if (bi >= 0) selmask |= 1u << bi; }
    }
    const float slope2 = exp2f(-(8.0f * (float)(h + 1)) / 6.0f) * LOG2E;
    const float cl = -slope2 * (float)(tq - 4 * hi);
    constexpr float THR = 6.0f;
    constexpr float ZERO_AT = -140.0f;
    float mref = 0.f, l = 0.f;
    f32x16 o0 = (f32x16){0.f, 0.f, 0.f, 0.f, 0.f, 0.f, 0.f, 0.f, 0.f, 0.f, 0.f, 0.f, 0.f, 0.f, 0.f, 0.f}, o1 = o0;
    const int sc = wid >> 1;
    const bf16* kvsrc = (wid & 1) ? proj + (size_t)(b * SEQ + sc * 64 + (lane >> 2)) * NINP + COL_MV + h * 64 + 8 * (lane & 3)
                                  : proj + (size_t)(b * SEQ + sc * 64 + lane) * NINP + COL_MK + h * 64;
#define MB_STAGE(JB, BUFB) do { const bf16* sp_ = kvsrc + (size_t)((JB) * 256) * NINP; LAS unsigned char* dp_ = lds + (BUFB) + sc * 16384 + ((wid & 1) ? 8192 : 0); \
        _Pragma("unroll") for (int k_ = 0; k_ < 8; ++k_) { const bf16* g_ = (wid & 1) ? sp_ + (size_t)(16 * (k_ & 3)) * NINP + 32 * (k_ >> 2) : sp_ + 8 * k_; \
            __builtin_amdgcn_global_load_lds((const unsigned*)g_, (LAS unsigned*)(dp_ + ((wid & 1) ? (k_ >> 2) * 4096 + (k_ & 3) * 1024 : k_ * 1024)), 16, 0, 0); } } while (0)
    MB_STAGE(ob, 0);
    asm volatile("s_waitcnt vmcnt(0)" ::: "memory");
    __syncthreads();
    unsigned pastmask = 0u;
    { float qnmax = wq[0];
#pragma unroll
      for (int w = 1; w < 8; ++w) qnmax = fmaxf(qnmax, wq[w]);
      float m4 = fmaxf(knv, __shfl_xor(knv, 1)); m4 = fmaxf(m4, __shfl_xor(m4, 2));
      const float kown = readlane_f(m4, 4 * ob);
      const float mref_lb = fminf(0.f, -(qnmax * kown) - THR);
      for (int jb = 0; jb < ob; ++jb) { const float ub = qnmax * readlane_f(m4, 4 * jb) + slope2 * (float)(jb * 256 + 255 - ob * 256) - mref_lb; if (ub > ZERO_AT) pastmask |= 1u << jb; } }
    int jb = ob;
    for (int it = 0;; ++it) {
        const int bufb = (it & 1) * 65536;
        const int nj = pastmask ? 31 - __builtin_clz(pastmask) : -1;
        if (nj >= 0) MB_STAGE(nj, bufb ^ 65536);
        const bool own = (jb == ob);
        const bool lanesel = own ? true : (((selmask >> jb) & 1u) != 0u);
        bool nd[4];
#pragma unroll
        for (int c = 0; c < 4; ++c) { const int kvb = jb * 256 + c * 64;
            if (own) nd[c] = (2 * c <= wid);
            else { const float ub = fmaf(qn, readlane_f(knv, jb * 4 + c), slope2 * (float)(kvb + 63 - tq)) - mref;
                   nd[c] = __builtin_amdgcn_ballot_w64(lanesel && (ub > ZERO_AT)) != 0ull; } }
        if (!own && nd[0] && nd[1] && nd[2] && nd[3]) {
            f32x16 a0, a1, b0, b1; const int kv0 = jb * 256;
            MB_INIT(a0, a1, kv0); qk_tile_c(a0, a1, a0, a1, lds + bufb, qf, r32, hi);
            MB_INIT(b0, b1, kv0 + 64); qk_tile_c(b0, b1, b0, b1, lds + bufb + 16384, qf, r32, hi);
            MB_SOFTMAX(a0, a1, true, b0, b1); pv_tile(o0, o1, lds + bufb + 8192, a0, a1, hi, q4, p4, blk);
            MB_INIT(a0, a1, kv0 + 128); qk_tile_c(a0, a1, a0, a1, lds + bufb + 32768, qf, r32, hi);
            MB_SOFTMAX(b0, b1, true, a0, a1); pv_tile(o0, o1, lds + bufb + 16384 + 8192, b0, b1, hi, q4, p4, blk);
            MB_INIT(b0, b1, kv0 + 192); qk_tile_c(b0, b1, b0, b1, lds + bufb + 49152, qf, r32, hi);
            MB_SOFTMAX(a0, a1, true, b0, b1); pv_tile(o0, o1, lds + bufb + 32768 + 8192, a0, a1, hi, q4, p4, blk);
            MB_SOFTMAX(b0, b1, false, a0, a1); pv_tile(o0, o1, lds + bufb + 49152 + 8192, b0, b1, hi, q4, p4, blk);
        } else {
#pragma unroll 1
        for (int c = 0; c < 4; ++c) {
            const int kvb = jb * 256 + c * 64, buf = bufb + c * 16384;
            const bool need = c == 0 ? nd[0] : c == 1 ? nd[1] : c == 2 ? nd[2] : nd[3];
            if (need) {
                f32x16 p0, p1;
                MB_INIT(p0, p1, kvb);
                qk_tile_c(p0, p1, p0, p1, lds + buf, qf, r32, hi);
                if (own && (2 * c + 1 >= wid)) {
                    const int dq = tq - kvb - 4 * hi;
#pragma unroll
                    for (int r = 0; r < 16; ++r) { p0[r] = (crow16(r) <= dq) ? p0[r] : -1e30f; p1[r] = (crow16(r) + 32 <= dq) ? p1[r] : -1e30f; }
                }
                MB_SOFTMAX(p0, p1, false, p0, p1);
                pv_tile(o0, o1, lds + buf + 8192, p0, p1, hi, q4, p4, blk);
            }
        }
        }
        asm volatile("s_waitcnt vmcnt(0)" ::: "memory");
        __syncthreads();
        if (nj < 0) break;
        pastmask &= ~(1u << nj); jb = nj;
    }
    l += __shfl_xor(l, 32);
    const float inv = 1.0f / l;
#pragma unroll
    for (int r = 0; r < 16; ++r) { o0[r] *= inv; o1[r] *= inv; }
    store_ot(mix + (size_t)(b * SEQ + tq) * D + 384 + h * 64, o0, o1, hi);
#undef MB_STAGE
}

__device__ __forceinline__ void ret_unit(Frame& F, const bf16* proj, bf16* mix, const bf16* state, int b, int h, int u) {
    const int tid = F.tid, lane = F.lane, wid = F.wave, r32 = lane & 31, hi = lane >> 5, q4 = (lane & 15) >> 2, p4 = lane & 3, blk = (lane >> 4) & 1;
    LAS unsigned char* lds = F.lds + RING_OFF;
    const int cc = wid >> 2, ww = wid & 3, n = 2 * u + cc, i = 32 * ww + r32;
    const size_t trow = (size_t)(b * SEQ + n * 128 + i);
    const float lg2 = log2f(1.0f - exp2f(-5.0f - (float)h));
    v2u pr[8];
#pragma unroll
    for (int k = 0; k < 8; ++k) { const int p = tid + 512 * k, c_ = p >> 11, kv_ = (k >> 1) & 1, row = (p >> 3) & 127, ch = p & 7;
        pr[k] = proj8_raw(proj + (size_t)(b * SEQ + (2 * u + c_) * 128 + row) * NINP, (kv_ ? COL_RV : COL_RK) + h * 64 + ch * 8); }
#pragma unroll
    for (int k = 0; k < 8; ++k) { const int p = tid + 512 * k, c_ = p >> 11, kv_ = (k >> 1) & 1, row = (p >> 3) & 127, ch = p & 7, kvr = row & 63;
        const int dst = c_ * 32768 + (row >> 6) * 16384 + (kv_ ? 8192 + (ch >> 2) * 4096 + kvr * 64 + (ch & 3) * 16 : ch * 1024 + kvr * 16);
        *(LAS v4u*)(lds + dst) = i8x8_bf(pr[k], kv_ ? 1.0f / 32.0f : 0.125f / 32.0f); }
    const bf16* qp = proj + trow * NINP;
    bf16x8 qf[4];
#pragma unroll
    for (int d0 = 0; d0 < 4; ++d0) qf[d0] = __builtin_bit_cast(bf16x8, i8x8_bf(proj8_raw(qp, COL_RQ + h * 64 + hi * 8 + d0 * 16), 1.0f / 32.0f));
    f32x16 o0 = (f32x16){0.f, 0.f, 0.f, 0.f, 0.f, 0.f, 0.f, 0.f, 0.f, 0.f, 0.f, 0.f, 0.f, 0.f, 0.f, 0.f}, o1 = o0;
    { const bf16* st = state + ((size_t)((b * NH + h) * 32 + n)) * 4096 + hi * 8;
#pragma unroll
      for (int d0 = 0; d0 < 4; ++d0) {
#pragma unroll
        for (int c2 = 0; c2 < 2; ++c2) { const v4u w = *(const GAS v4u*)(st + (size_t)(32 * c2 + r32) * 64 + d0 * 16);
            if (c2) o1 = mfma32(__builtin_bit_cast(bf16x8, w), qf[d0], o1); else o0 = mfma32(__builtin_bit_cast(bf16x8, w), qf[d0], o0); } } }
    { const float xi = ex2(lg2 * (float)(i + 1));
#pragma unroll
      for (int r = 0; r < 16; ++r) { o0[r] *= xi; o1[r] *= xi; } }
    __syncthreads();
#pragma unroll 1
    for (int c = 0; c < 2; ++c) {
        if (2 * c <= ww) {
            f32x16 p0, p1;
            const LAS unsigned char* tb = lds + cc * 32768 + c * 16384;
            qk_tile(p0, p1, tb, qf, r32, hi);
            const int dq = i - 64 * c - 4 * hi;
#pragma unroll
            for (int r = 0; r < 16; ++r) { const int d0i = dq - crow16(r), d1i = d0i - 32;
                p0[r] = d0i >= 0 ? p0[r] * ex2(lg2 * (float)d0i) : 0.f; p1[r] = d1i >= 0 ? p1[r] * ex2(lg2 * (float)d1i) : 0.f; }
            pv_tile(o0, o1, tb + 8192, p0, p1, hi, q4, p4, blk);
        }
    }
    float s = 0.f;
#pragma unroll
    for (int r = 0; r < 16; ++r) s += o0[r] + o1[r];
    s += __shfl_xor(s, 32);
    const float mean = s * (1.0f / 64.0f); float vs = 0.f;
#pragma unroll
    for (int r = 0; r < 16; ++r) { o0[r] -= mean; o1[r] -= mean; vs += o0[r] * o0[r] + o1[r] * o1[r]; }
    vs += __shfl_xor(vs, 32);
    const float rstd = 1.0f / sqrtf(vs * (1.0f / 64.0f) + 1e-5f);
#pragma unroll
    for (int c2 = 0; c2 < 2; ++c2)
#pragma unroll
        for (int g = 0; g < 4; ++g) { const f32x4 gv = proj4(proj + trow * NINP, COL_RG + h * 64 + 32 * c2 + 8 * g + 4 * hi); f32x16& o = c2 ? o1 : o0;
            o[4 * g] *= rstd * silu(gv[0]); o[4 * g + 1] *= rstd * silu(gv[1]); o[4 * g + 2] *= rstd * silu(gv[2]); o[4 * g + 3] *= rstd * silu(gv[3]); }
    store_ot(mix + trow * D + h * 64, o0, o1, hi);
    __syncthreads();
}

__device__ __forceinline__ void kv_load(v2u (&pr)[8], int tid, const bf16* proj, int b, int h, int u) {
#pragma unroll
    for (int k = 0; k < 8; ++k) { const int p = tid + 512 * k, c_ = p >> 11, kv_ = (k >> 1) & 1, row = (p >> 3) & 127, ch = p & 7;
        pr[k] = proj8_raw(proj + (size_t)(b * SEQ + (2 * u + c_) * 128 + row) * NINP, (kv_ ? COL_RV : COL_RK) + h * 64 + ch * 8); }
}
__device__ __forceinline__ void kv_unit(Frame& F, const v2u (&pr)[8], float* state, int b, int h, int u) {
    const int tid = F.tid, lane = F.lane, wid = F.wave, r32 = lane & 31, hi = lane >> 5, q4 = (lane & 15) >> 2, p4 = lane & 3, blk = (lane >> 4) & 1;
    LAS unsigned char* lds = F.lds + RING_OFF;
    const float lg2 = log2f(1.0f - exp2f(-5.0f - (float)h));
#pragma unroll
    for (int k = 0; k < 8; ++k) { const int p = tid + 512 * k, c_ = p >> 11, kv_ = (k >> 1) & 1, row = (p >> 3) & 127, ch = p & 7;
        const v4u w = i8x8_bf(pr[k], kv_ ? 1.0f / 32.0f : ex2(lg2 * (float)(127 - row)) * (0.125f / 32.0f));
        *(LAS v4u*)(lds + c_ * 32768 + kv_ * 16384 + (ch >> 2) * 8192 + row * 64 + (ch & 3) * 16) = w; }
    __syncthreads();
    const int cc = wid >> 2, ce = (wid >> 1) & 1, cd = wid & 1, n = 2 * u + cc;
    const LAS unsigned char* kb = lds + cc * 32768 + cd * 8192 + (8 * hi + q4) * 64 + blk * 32 + p4 * 8;
    const LAS unsigned char* vb = lds + cc * 32768 + 16384 + ce * 8192 + (8 * hi + q4) * 64 + blk * 32 + p4 * 8;
    f32x16 acc = (f32x16){0.f, 0.f, 0.f, 0.f, 0.f, 0.f, 0.f, 0.f, 0.f, 0.f, 0.f, 0.f, 0.f, 0.f, 0.f, 0.f};
#pragma unroll
    for (int ks = 0; ks < 8; ++ks) {
        const bf16x8 a = cat8(trd(vb + ks * 1024), trd(vb + ks * 1024 + 256)), bq = cat8(trd(kb + ks * 1024), trd(kb + ks * 1024 + 256));
        acc = mfma32(a, bq, acc); }
    float* sp = state + ((size_t)((b * NH + h) * 32 + n)) * 4096 + (size_t)(32 * ce + 4 * hi) * 64 + 32 * cd + r32;
#pragma unroll
    for (int r = 0; r < 16; ++r) sp[crow16(r) * 64] = acc[r];
    __syncthreads();
}
__device__ __forceinline__ void kmean_unit(Frame& F, const bf16* proj, bf16* kmean, int b, int j) {
    LAS float* red = (LAS float*)(F.lds + RING_OFF);
    const int tid = F.tid;
    if (tid < 384) { const int cp = tid % 192, rg = tid / 192; float a0 = 0.f, a1 = 0.f;
        const bf16* p = proj + (size_t)(b * SEQ + j * 256 + rg * 128) * NINP + COL_MK + 2 * cp;
        for (int r = 0; r < 128; ++r) { const unsigned w = *(const GAS unsigned*)(p + (size_t)r * NINP); a0 += bflo(w); a1 += bfhi(w); }
        red[(rg * 192 + cp) * 2] = a0; red[(rg * 192 + cp) * 2 + 1] = a1; }
    __syncthreads();
    if (tid < 192) { const float m0 = (red[tid * 2] + red[(192 + tid) * 2]) * (1.0f / 256.0f), m1 = (red[tid * 2 + 1] + red[(192 + tid) * 2 + 1]) * (1.0f / 256.0f);
        const int col = 2 * tid, hh = col >> 6, d = col & 63;
        *(GAS unsigned*)(kmean + ((size_t)((b * NH + hh) * 16 + j)) * 64 + d) = pk2(m0, m1); }
    __syncthreads();
}
__device__ __forceinline__ void knorm_unit(Frame& F, const bf16* proj, float* knorm, int b, int j) {
    LAS float* nr = (LAS float*)(F.lds + RING_OFF);
    const int tid = F.tid, row = tid >> 1, h3 = (tid & 1) * 3;
    const bf16* p = proj + (size_t)(b * SEQ + j * 256 + row) * NINP + COL_MK + h3 * 64;
#pragma unroll
    for (int hh = 0; hh < 3; ++hh) { float ss = 0.f;
#pragma unroll
        for (int c = 0; c < 8; ++c) { const v4u w = *(const GAS v4u*)(p + hh * 64 + c * 8);
            ss += bflo(w.x) * bflo(w.x) + bfhi(w.x) * bfhi(w.x) + bflo(w.y) * bflo(w.y) + bfhi(w.y) * bfhi(w.y) + bflo(w.z) * bflo(w.z) + bfhi(w.z) * bfhi(w.z) + bflo(w.w) * bflo(w.w) + bfhi(w.w) * bfhi(w.w); }
        nr[row * 6 + h3 + hh] = ss; }
    __syncthreads();
    if (tid < 24) { const int c = tid / 6, hh = tid % 6; float mxs = 0.f; for (int r = 0; r < 64; ++r) mxs = fmaxf(mxs, nr[(64 * c + r) * 6 + hh]);
        knorm[(size_t)(b * NH + hh) * 64 + j * 4 + c] = sqrtf(mxs) * 1.0001f; }
    __syncthreads();
}
__device__ __forceinline__ void prep_phase(const Frame& F0, const bf16* proj, float* state, bf16* kmean, float* knorm) {
    Frame F = phase_frame(F0);
    { v2u pr[8], prn[8]; int u2 = F.vcu;
      if (u2 < BATCH * NH * 16) kv_load(pr, F.tid, proj, (u2 >> 4) / NH, (u2 >> 4) % NH, u2 & 15);
      for (; u2 < BATCH * NH * 16; u2 += F.G) { const int bh = u2 >> 4, un = u2 + F.G;
          if (un < BATCH * NH * 16) kv_load(prn, F.tid, proj, (un >> 4) / NH, (un >> 4) % NH, un & 15);
          kv_unit(F, pr, state, bh / NH, bh % NH, u2 & 15);
#pragma unroll
          for (int k = 0; k < 8; ++k) pr[k] = prn[k]; } }
    for (int u2 = F.vcu; u2 < 2 * BATCH * 16; u2 += F.G) { const int v2 = u2 & (BATCH * 16 - 1);
        if (u2 < BATCH * 16) kmean_unit(F, proj, kmean, v2 >> 4, v2 & 15); else knorm_unit(F, proj, knorm, v2 >> 4, v2 & 15); }
}
__device__ __forceinline__ void scan_phase(const Frame& F0, const float* state, bf16* prev) {
    Frame F = phase_frame(F0);
    const int gt = F.vcu * (NWAVES * 64) + F.tid, NGT = F.G * NWAVES * 64;
    for (int idx = gt; idx < BATCH * NH * 2048; idx += NGT) { const int bh = idx >> 11, el = (idx & 2047) * 2, h = bh % NH;
        const float cd = exp2f(128.0f * log2f(1.0f - exp2f(-5.0f - (float)h)));
        const float* p = state + (size_t)bh * 32 * 4096 + el; unsigned* q = (unsigned*)(prev + (size_t)bh * 32 * 4096 + el);
        f32x2_t kv[32];
#pragma unroll
        for (int n = 0; n < 32; ++n) kv[n] = *(const GAS f32x2_t*)(p + (size_t)n * 4096);
        float s0 = 0.f, s1 = 0.f;
#pragma unroll
        for (int n = 0; n < 32; ++n) { q[(size_t)n * 2048] = pk2(s0, s1); s0 = s0 * cd + kv[n].x; s1 = s1 * cd + kv[n].y; } }
}
__device__ __forceinline__ void gmlp_unit(Frame& F, const bf16* proj, bf16* mix, const bf16* gwb, const float* gb, int b, int n) {
    const int lane = F.lane, wid = F.wave, r32 = lane & 31, hi = lane >> 5, q4 = (lane & 15) >> 2, p4 = lane & 3, blk = (lane >> 4) & 1;
    LAS unsigned char* lds = F.lds + RING_OFF;
    f32x4 rawv[16];
#pragma unroll
    for (int k = 0; k < 16; ++k) rawv[k] = proj4(proj + (size_t)(b * SEQ + n * 128 + wid * 16 + k) * NINP, COL_GV + 4 * lane);
#pragma unroll
    for (int k = 0; k < 16; ++k) { const int j = wid * 16 + k;
        const f32x4 raw = rawv[k];
        float x0 = gelu_tanh(raw[0]), x1 = gelu_tanh(raw[1]), x2 = gelu_tanh(raw[2]), x3 = gelu_tanh(raw[3]);
        const float mean = wave_sum((x0 + x1) + (x2 + x3)) * (1.0f / 256.0f);
        x0 -= mean; x1 -= mean; x2 -= mean; x3 -= mean;
        const float rstd = 1.0f / sqrtf(wave_sum((x0 * x0 + x1 * x1) + (x2 * x2 + x3 * x3)) * (1.0f / 256.0f) + 1e-5f);
        const int g = lane >> 4, c = 4 * (lane & 15);
        *(LAS v2u*)(lds + g * 16384 + (c >> 5) * 8192 + j * 64 + (c & 31) * 2) = (v2u){pk2(x0 * rstd, x1 * rstd), pk2(x2 * rstd, x3 * rstd)}; }
    __syncthreads();
    const int g = wid & 3;
    const LAS unsigned char* vb = lds + g * 16384 + (8 * hi + q4) * 64 + blk * 32 + p4 * 8;
    for (int k2 = 0; k2 < 2; ++k2) {
        const int it = (wid >> 2) ? (1 + k2) : (3 * k2);
        const int i = 32 * it + r32;
        f32x16 o0 = (f32x16){0.f, 0.f, 0.f, 0.f, 0.f, 0.f, 0.f, 0.f, 0.f, 0.f, 0.f, 0.f, 0.f, 0.f, 0.f, 0.f}, o1 = o0;
        const bf16* wp = gwb + ((size_t)(g * 128 + i)) * 128 + 8 * hi;
        bf16x8 wfv[8];
#pragma unroll
        for (int s = 0; s < 8; ++s) wfv[s] = *(const bf16x8*)(wp + 16 * s);
#pragma unroll
        for (int s = 0; s < 8; ++s) { if (s >= 2 * it + 2) break;
            const bf16x8 wf = wfv[s];
            const bf16x8 v0 = cat8(trd(vb + s * 1024), trd(vb + s * 1024 + 256)), v1 = cat8(trd(vb + 8192 + s * 1024), trd(vb + 8192 + s * 1024 + 256));
            o0 = mfma32(v0, wf, o0); o1 = mfma32(v1, wf, o1); }
        const float bias = gb[g * 128 + i];
        const size_t trow = (size_t)(b * SEQ + n * 128 + i);
#pragma unroll
        for (int c2 = 0; c2 < 2; ++c2)
#pragma unroll
            for (int gg = 0; gg < 4; ++gg) { const f32x4 uv = proj4(proj + trow * NINP, COL_GU + g * 64 + 32 * c2 + 8 * gg + 4 * hi); f32x16& o = c2 ? o1 : o0;
                o[4 * gg] = gelu_tanh(uv[0]) * (o[4 * gg] + bias); o[4 * gg + 1] = gelu_tanh(uv[1]) * (o[4 * gg + 1] + bias);
                o[4 * gg + 2] = gelu_tanh(uv[2]) * (o[4 * gg + 2] + bias); o[4 * gg + 3] = gelu_tanh(uv[3]) * (o[4 * gg + 3] + bias); }
        store_ot(mix + trow * D + 768 + g * 64, o0, o1, hi);
    }
    __syncthreads();
}
__device__ __forceinline__ void mixer_phase(const Frame& F0, const bf16* proj, bf16* mix, const bf16* state, const bf16* kmean, const float* knorm, const bf16* gwb, const float* gb, unsigned* qhead, unsigned char* ws_conv, bool dense) {
    Frame F = phase_frame(F0);
    constexpr int NMOBA = BATCH * NH * 16, NRET = BATCH * NH * 16, NGM = BATCH * 32, NU = NMOBA + NRET + NGM;
    LAS int* qslot = (LAS int*)(F.lds + LDSCTL_OFF + 128);
    int cur = F.vcu;
#define MIXQ_NEXT() do { if (dense ? cur < 224 : cur < 1792 - 256) moe_conv_unit(F, ws_conv, dense ? cur : 256 + cur, dense ? 0 : 3); if (F.tid == 0) *qslot = nxt; __syncthreads(); cur = *qslot; } while (0)
#define MIXQ_REQ() int nxt = 0; if (F.tid == 0) nxt = F.G + (int)__hip_atomic_fetch_add(qhead, 1u, __ATOMIC_RELAXED, __HIP_MEMORY_SCOPE_AGENT)
    constexpr int NM1 = 12 * BATCH * NH;
    while (cur < NM1) { MIXQ_REQ();
        const int ob = 15 - cur / (BATCH * NH), q = cur % (BATCH * NH), h = NH - 1 - q / BATCH, b = q % BATCH; moba_unit(F, proj, mix, kmean, knorm, b, h, ob);
        MIXQ_NEXT(); }
    while (cur < NM1 + NGM) { MIXQ_REQ();
        const int u2 = cur - NM1; gmlp_unit(F, proj, mix, gwb, gb, u2 >> 5, u2 & 31);
        MIXQ_NEXT(); }
    while (cur < NMOBA + NGM) { MIXQ_REQ();
        const int c2 = cur - NGM, ob = 15 - c2 / (BATCH * NH), q = c2 % (BATCH * NH), h = NH - 1 - q / BATCH, b = q % BATCH; moba_unit(F, proj, mix, kmean, knorm, b, h, ob);
        MIXQ_NEXT(); }
    while (cur < NU) { MIXQ_REQ();
        const int u2 = cur - NMOBA - NGM, bh = u2 >> 4; ret_unit(F, proj, mix, state, bh / NH, bh % NH, u2 & 15);
        MIXQ_NEXT(); }
#undef MIXQ_NEXT
#undef MIXQ_REQ
}

__device__ __forceinline__ void router_phase(const Frame& F0, const bf16* x, const float* gain, const float* router, bf16* H, v4u* sel, int* counts) {
    Frame F = phase_frame(F0);
    LAS float* Rt = (LAS float*)(F.lds + RING_OFF);
    LAS int* cntw = (LAS int*)(F.lds + RING_OFF + 32768);
    for (int i = F.tid; i < 8192; i += NWAVES * 64) { const int k = i >> 3, e = i & 7; Rt[e * 1024 + k] = router[i]; }
    __syncthreads();
    int cw[16];
#pragma unroll
    for (int q = 0; q < 16; ++q) cw[q] = 0;
    f32x4 gn[4];
#pragma unroll
    for (int j = 0; j < 4; ++j) gn[j] = *((const GAS f32x4*)gain + F.lane + 64 * j);
    const int m0 = F.vcu * 128 + F.wave * 16;
    f32x4 vn[4];
#pragma unroll
    for (int j = 0; j < 4; ++j) vn[j] = bf4(*((const GAS v2u*)(x + (size_t)m0 * XLD) + F.lane + 64 * j));
    const bool up5 = (F.lane & 32) != 0, up4 = (F.lane & 16) != 0, up3 = (F.lane & 8) != 0;
    for (int k = 0; k < 16; ++k) { const int m = m0 + k;
        f32x4 v[4]; float s = 0.f;
#pragma unroll
        for (int j = 0; j < 4; ++j) { v[j] = vn[j]; s += (v[j].x * v[j].x + v[j].y * v[j].y) + (v[j].z * v[j].z + v[j].w * v[j].w); }
        if (k + 1 < 16) {
#pragma unroll
            for (int j = 0; j < 4; ++j) vn[j] = bf4(*((const GAS v2u*)(x + (size_t)(m + 1) * XLD) + F.lane + 64 * j)); }
        const float rstd = 1.f / sqrtf(wave_sum(s) * (1.f / D) + 1e-6f);
        GAS unsigned* o8 = (GAS unsigned*)((unsigned char*)H + (size_t)m * D) + F.lane;
        float lg[8];
#pragma unroll
        for (int e = 0; e < 8; ++e) lg[e] = 0.f;
#pragma unroll
        for (int j = 0; j < 4; ++j) { const f32x4 y = v[j] * rstd * gn[j]; o8[64 * j] = MOE_GU_I8 ? pg8::pk4_i8(y.x * AI8_SCALE, y.y * AI8_SCALE, y.z * AI8_SCALE, y.w * AI8_SCALE) : pk4_fp8(y.x * A8_SCALE, y.y * A8_SCALE, y.z * A8_SCALE, y.w * A8_SCALE);
#pragma unroll
            for (int e = 0; e < 8; ++e) { const f32x4 rr = *(const LAS f32x4*)(Rt + e * 1024 + 256 * j + 4 * F.lane); lg[e] += (y.x * rr.x + y.y * rr.y) + (y.z * rr.z + y.w * rr.w); } }
        float t4[4], t2[2], t1;
#pragma unroll
        for (int i = 0; i < 4; ++i) { const float give = up5 ? lg[i] : lg[4 + i], keep = up5 ? lg[4 + i] : lg[i]; t4[i] = keep + __shfl_xor(give, 32); }
#pragma unroll
        for (int i = 0; i < 2; ++i) { const float give = up4 ? t4[i] : t4[2 + i], keep = up4 ? t4[2 + i] : t4[i]; t2[i] = keep + __shfl_xor(give, 16); }
        { const float give = up3 ? t2[0] : t2[1], keep = up3 ? t2[1] : t2[0]; t1 = keep + __shfl_xor(give, 8); }
        t1 += __shfl_xor(t1, 4); t1 += __shfl_xor(t1, 2); t1 += __shfl_xor(t1, 1);
#pragma unroll
        for (int e = 0; e < 8; ++e) lg[e] = readlane_f(t1, 8 * e);
        int e0 = 0; float v0 = lg[0];
#pragma unroll
        for (int e = 1; e < 8; ++e) if (lg[e] > v0) { v0 = lg[e]; e0 = e; }
        int e1 = -1; float v1 = -__builtin_inff();
#pragma unroll
        for (int e = 0; e < 8; ++e) if (e != e0 && lg[e] > v1) { v1 = lg[e]; e1 = e; }
        const float g0 = 1.0f / (1.0f + expf(v1 - v0)), g1 = 1.0f - g0;
        if (F.lane == 0) sel[m] = (v4u){(unsigned)e0 | ((unsigned)e1 << 8), __float_as_uint(g0), __float_as_uint(g1), 0u};
#pragma unroll
        for (int e = 0; e < 8; ++e) { cw[e] += (e0 == e) ? 1 : 0; cw[8 + e] += (e1 == e) ? 1 : 0; }
    }
    if (F.lane == 0) {
#pragma unroll
        for (int q = 0; q < 16; ++q) cntw[F.wave * 16 + q] = cw[q]; }
    __syncthreads();
    if (F.tid < 16) { int sacc = 0; for (int w2 = 0; w2 < 8; ++w2) sacc += cntw[w2 * 16 + F.tid]; counts[F.vcu * 16 + F.tid] = sacc; }
    __syncthreads();
}
__device__ __forceinline__ void lists_phase(const Frame& F0, const v4u* sel, const int* counts, int* rowtok, float* rowgate, int* tiletab, int* tokpos) {
    Frame F = phase_frame(F0);
    LAS int* part = (LAS int*)(F.lds + RING_OFF);
    LAS int* prein = part + 512, *tot = prein + 16, *bef = tot + 16, *gstart = bef + 16, *gbase = gstart + 16;
    const int t = F.tid & 15, pr = F.tid >> 4, w = F.vcu;
    { int sfull = 0, spre = 0;
      for (int k = 0; k < 8; ++k) { const int c = counts[(8 * pr + k) * 16 + t]; sfull += c; if (8 * pr + k < w) spre += c; }
      part[pr * 16 + t] = sfull; if (pr == (w >> 3)) prein[t] = spre; }
    __syncthreads();
    if (F.tid < 16) { int s = 0, bsum = 0; for (int p2 = 0; p2 < 32; ++p2) { const int c = part[p2 * 16 + t]; s += c; if (p2 < (w >> 3)) bsum += c; } tot[t] = s; bef[t] = bsum + prein[t]; }
    __syncthreads();
    if (F.tid < 16) { const int slot = t >> 3, e = t & 7; int gs = 0; for (int e2 = 0; e2 < e; ++e2) gs += (tot[slot * 8 + e2] + 255) & ~255; gstart[t] = gs; gbase[t] = gs + bef[t]; }
    __syncthreads();
    if (F.wave == 0) {
        int run[16];
#pragma unroll
        for (int q = 0; q < 16; ++q) run[q] = 0;
        for (int rd = 0; rd < 2; ++rd) { const int tok = w * 128 + rd * 64 + F.lane; const v4u sv = sel[tok];
            const int e0 = sv.x & 255, e1 = (sv.x >> 8) & 255; int pos0 = 0, pos1 = 0;
            const unsigned long long lt = (1ull << F.lane) - 1ull;
#pragma unroll
            for (int e = 0; e < 8; ++e) {
                const unsigned long long m0 = __builtin_amdgcn_ballot_w64(e0 == e), m1 = __builtin_amdgcn_ballot_w64(e1 == e);
                if (e0 == e) pos0 = gbase[e] + run[e] + __builtin_popcountll(m0 & lt);
                if (e1 == e) pos1 = gbase[8 + e] + run[8 + e] + __builtin_popcountll(m1 & lt);
                run[e] += __builtin_popcountll(m0); run[8 + e] += __builtin_popcountll(m1); }
            rowtok[pos0] = tok; rowgate[pos0] = __uint_as_float(sv.y);
            rowtok[MOE_ROWS + pos1] = tok; rowgate[MOE_ROWS + pos1] = __uint_as_float(sv.z);
            tokpos[tok] = pos0; tokpos[T + tok] = MOE_ROWS + pos1; }
    }
    if (w == 0) {
        for (int idx = F.tid; idx < 16 * 256; idx += NWAVES * 64) { const int q = idx >> 8, k = idx & 255, slot = q >> 3, padn = ((tot[q] + 255) & ~255) - tot[q];
            if (k < padn) { rowtok[slot * MOE_ROWS + gstart[q] + tot[q] + k] = -1; rowgate[slot * MOE_ROWS + gstart[q] + tot[q] + k] = 0.f; } }
        if (F.tid < 16) { const int slot = t >> 3, e = t & 7, t0 = gstart[t] >> 8, nt_ = (tot[t] + 255) >> 8;
            for (int k = 0; k < nt_; ++k) tiletab[16 + slot * MOE_TILES + t0 + k] = e;
            if (e == 7) tiletab[slot] = t0 + nt_; }
    }
    __syncthreads();
}
#ifndef MK_PER_PHASE
#define MK_PER_PHASE 0
#endif
constexpr int N_PHASES = 21;
static_assert(RING_OFF == 0 && pg8::STAGE_BYTES + 4096 + NWAVES * 1024 <= LDS_BYTES && MISC_OFF + 1024 <= RING_BYTES + 4096, "the gathered GEMM's per-wave row lists sit at [132K, 140K) of the LDS");
struct Args { const float* in[21]; float* out; unsigned char* ws; int ph_lo, ph_hi, use_bar, pad; };
#define RUN(p) (lo <= (p) && (p) < hi)
#define SEAM(p) do { if (lo <= (p) && (p) + 1 < hi) { int z_ = 0; asm volatile("" : "+v"(z_)); z_ = __builtin_amdgcn_readfirstlane(z_); XcdBarrier b2_ = bar; b2_.bar += z_; b2_.x += (unsigned)z_; xcd_barrier(b2_); } } while (0)
#define WSP(off) (arg_ws() + (off))
#define DO(p, ...) do { if (RUN(p)) { __VA_ARGS__ } } while (0)
template <int LAYER> __device__ __forceinline__ void layer_phases(const Frame& F, const XcdBarrier& bar, int lo, int hi) {
        constexpr int pb = LAYER * 9;
        DO(pb + 1, {
            pg8::Gemm g{(const bf16*)WSP(WS_H), (const bf16*)WSP(LAYER ? WS_WIN1 : WS_WIN0), D, 0, nullptr, D};
            pg8::StaticOrder S; S.init(T / 256, NINP / 256, F.G, (int)blockIdx.x, nullptr, 1, 0);
            pg8::EpiBf16 E{(bf16*)WSP(WS_BIG), NINP, LAYER ? (const unsigned long long*)((const unsigned*)WSP(WS_CTL) + CW_SSQ + 2 * T) : nullptr,
                           WIN_I8 ? 1.0f / ((LAYER ? HI8_SCALE : AI8_SCALE) * WI8_SCALE) : 1.0f, COL_RK, COL_RV, WIN_I8 ? 0.125f : 1.0f, COL_MQ, COL_MK, WIN_I8 ? 0.125f * LOG2E : 1.0f,
                           0, COL_MK, COL_GU, NIN};
            pg8::gemm_phase<pg8::EpiBf16, pg8::StaticOrder, false, false, WIN_I8 ? 3 : 0>(F.lds + RING_OFF, g, S, E, F.wave);
            static_assert((T / 256) * (NINP / 256) == 6 * 256 + 128, "idle half round");
            if ((int)blockIdx.x >= 128) { Frame Fc = phase_frame(F); moe_conv_unit(Fc, WSP(0), LAYER * 128 + ((int)blockIdx.x - 128)); }
        });
        SEAM(pb + 1);
        DO(pb + 2, prep_phase(F, (const bf16*)WSP(WS_BIG), (float*)WSP(WS_BIG + BIG_STATE), (bf16*)WSP(WS_MISC + MS_KMEAN), (float*)WSP(WS_MISC + MS_KNORM)););
        SEAM(pb + 2);
        if (RUN(pb + 3)) scan_phase(F, (const float*)WSP(WS_BIG + BIG_STATE), (bf16*)WSP(WS_STATEB));
        SEAM(pb + 3);
        DO(pb + 4, mixer_phase(F, (const bf16*)WSP(WS_BIG), (bf16*)WSP(WS_H), (const bf16*)WSP(WS_STATEB), (const bf16*)WSP(WS_MISC + MS_KMEAN), (const float*)WSP(WS_MISC + MS_KNORM),
                                     (const bf16*)WSP(WS_MISC + MS_GW) + (size_t)LAYER * 65536, arg_in(LAYER ? 14 : 5), (unsigned*)WSP(WS_CTL) + CW_MIXQ + 64 * LAYER, WSP(0), LAYER == 0););
        SEAM(pb + 4);
        DO(pb + 5, {
            pg8::Gemm g{(const bf16*)WSP(WS_H), (const bf16*)WSP(LAYER ? WS_WOUT1 : WS_WOUT0), D, 0, nullptr, D};
            pg8::StaticOrder S; S.init(T / 256, D / 256, F.G, (int)blockIdx.x, nullptr, 1, 0);
            pg8::EpiResF32 E{LAYER ? (const void*)arg_out() : (const void*)arg_in(0), (bf16*)arg_out(), LAYER ? XLD : D, XLD, LAYER == 0};
            pg8::gemm_phase<pg8::EpiResF32, pg8::StaticOrder, false>(F.lds + RING_OFF, g, S, E, F.wave);
        });
        SEAM(pb + 5);
        if constexpr (LAYER == 0) {
            DO(6, if (DENSE_GU_FP8) norm8_phase(F, arg_out(), arg_in(6), WSP(WS_H), DENSE_GU_I8 != 0, true); else norm_phase(F, arg_out(), arg_in(6), (bf16*)WSP(WS_H)););
            SEAM(6);
            constexpr int GU0_MODE = !DENSE_GU_FP8 ? 0 : DENSE_GU_I8 ? 3 : 2;
            constexpr float GU0_SCALE = !DENSE_GU_FP8 ? 1.0f : DENSE_GU_I8 ? 1.0f / (AI8_SCALE * WI8_SCALE) : 1.0f / (A8_SCALE * W8_SCALE);
            constexpr int NF8 = DENSE_DN_FP8 == 1 ? T / 256 : DENSE_DN_FP8 == 2 ? T / 512 : 0;
            static_assert((size_t)NF8 * 256 * FF <= (size_t)NF8 * 256 * FF * 2 && (size_t)T * FF * 2 <= WS_END - WS_BIG, "hidden buffers");
            DO(7, {
                pg8::Gemm g{(const bf16*)WSP(WS_H), (const bf16*)WSP(WS_WGU0), D, 0, nullptr, D};
                if constexpr (NF8 > 0) {
                    pg8::StaticOrder S; S.init(NF8, 2 * FF / 256, F.G, (int)blockIdx.x, nullptr, 1, 0);
                    pg8::EpiSwiGLU8 E{WSP(WS_BIG), FF, GU0_SCALE, A8_SCALE};
                    pg8::gemm_phase<pg8::EpiSwiGLU8, pg8::StaticOrder, false, false, GU0_MODE>(F.lds + RING_OFF, g, S, E, F.wave); }
                if constexpr (NF8 < T / 256) {
                    pg8::StaticOrder S; S.init(T / 256 - NF8, 2 * FF / 256, F.G, (int)blockIdx.x, nullptr, 1, 0); S.gap_at = 0; S.gap = NF8;
                    pg8::EpiSwiGLU E{(bf16*)WSP(WS_BIG), FF, nullptr, GU0_SCALE};
                    pg8::gemm_phase<pg8::EpiSwiGLU, pg8::StaticOrder, false, false, GU0_MODE>(F.lds + RING_OFF, g, S, E, F.wave); }
            });
            SEAM(7);
            DO(8, {
                if constexpr (NF8 > 0) {
                    pg8::Gemm g{(const bf16*)WSP(WS_BIG), (const bf16*)WSP(WS_WDN0F8), FF, 0, nullptr, FF};
                    pg8::StaticOrder S; S.init(NF8, D / 256, F.G, (int)blockIdx.x, nullptr, 1, 0);
                    pg8::EpiResNorm E{(bf16*)arg_out(), XLD, arg_in(10), (void*)WSP(WS_H), D, (unsigned long long*)((unsigned*)WSP(WS_CTL) + CW_SSQ + 2 * T), 1.0f / (A8_SCALE * W8_SCALE), WIN_I8 ? HI8_SCALE : 0.f};
                    pg8::gemm_phase<pg8::EpiResNorm, pg8::StaticOrder, false, false, 2>(F.lds + RING_OFF, g, S, E, F.wave); }
                if constexpr (NF8 < T / 256) {
                    pg8::Gemm g{(const bf16*)WSP(WS_BIG), (const bf16*)WSP(WS_WDN0), FF, 0, nullptr, FF};
                    pg8::StaticOrder S; S.init(T / 256 - NF8, D / 256, F.G, (int)blockIdx.x, nullptr, 1, 0); S.gap_at = 0; S.gap = NF8;
                    pg8::EpiResNorm E{(bf16*)arg_out(), XLD, arg_in(10), (void*)WSP(WS_H), D, (unsigned long long*)((unsigned*)WSP(WS_CTL) + CW_SSQ + 2 * T), 1.0f, WIN_I8 ? HI8_SCALE : 0.f};
                    pg8::gemm_phase<pg8::EpiResNorm, pg8::StaticOrder, false, false, 0>(F.lds + RING_OFF, g, S, E, F.wave); }
            });
            SEAM(8);
        }
    }
#ifndef MOE_FP8
#define MOE_FP8 2
#endif
constexpr int MOE_KSPLIT = 7;
constexpr size_t WS_SLAB2 = WS_WIN0;
constexpr size_t WS_Y = WS_H;
static_assert(WS_SLAB2 + (size_t)64 * MOE_KSPLIT * 262144 <= WS_WDN1, "slab");
__device__ __forceinline__ void moe_order(pg8::StaticOrder& S, const int* tiletab, int nN, int G, int c, int split, int part) {
    const int t0 = tiletab[0], t1 = tiletab[1];
    S.init(t0 + t1, nN, G, c, tiletab + 16, split, part); S.gap_at = t0; S.gap = MOE_TILES - t0;
}
__device__ __forceinline__ void moe_tiles_to_lds(const Frame& F, pg8::StaticOrder& S, const int* tiletab) {
    LAS int* tl = (LAS int*)(F.lds + LDS_BYTES - 4096);
    for (int i = F.tid; i < 2 * MOE_TILES; i += NWAVES * 64) tl[i] = tiletab[16 + i];
    __syncthreads();
    S.tile_l = tl;
}
__device__ __forceinline__ void final_combine_norm(const Frame& F0) {
    Frame F = phase_frame(F0);
    const int* tiletab = (const int*)WSP(WS_MISC + MS_TILETAB);
    pg8::StaticOrder S; moe_order(S, tiletab, D / 256, F.G, 0, MOE_KSPLIT, 1);
    const int R = S.nwg - S.nfull;
    LAS int* tab = (LAS int*)(F.lds + RING_OFF);
    for (int i = F.tid; i < 2 * MOE_TILES * 4; i += NWAVES * 64) tab[i] = -1;
    __syncthreads();
    for (int r = F.tid; r < R; r += NWAVES * 64) { int pm, pn; S.decode(S.nfull + r, pm, pn); tab[pm * 4 + pn] = r; }
    __syncthreads();
    const float* slab = (const float*)WSP(WS_SLAB2); const int* tokpos = (const int*)WSP(WS_MISC + MS_TOKPOS); const float* rowgate = (const float*)WSP(WS_MISC + MS_ROWGATE);
    float* xo = arg_out(); const bf16* y = (const bf16*)WSP(WS_Y); const float* gain = arg_in(20);
    f32x4 gn[4];
#pragma unroll
    for (int j = 0; j < 4; ++j) gn[j] = *((const GAS f32x4*)gain + F.lane + 64 * j);
    const int gw = F.vcu * NWAVES + F.wave, NGW = F.G * NWAVES;
    for (int m = gw; m < T; m += NGW) {
        GAS f32x4* xr = (GAS f32x4*)(xo + (size_t)m * D) + F.lane;
        const GAS v2u* xb = (const GAS v2u*)((const bf16*)xo + (size_t)m * XLD) + F.lane;
        const GAS v2u* yr = (const GAS v2u*)(y + (size_t)m * D) + F.lane;
        f32x4 v[4]; v2u xv[4], yv[4]; float s = 0.f;
#pragma unroll
        for (int j = 0; j < 4; ++j) { xv[j] = xb[64 * j]; yv[j] = yr[64 * j]; }
        const int g0 = tokpos[m], g1 = tokpos[T + m];
        int r0[4], r1[4];
#pragma unroll
        for (int j = 0; j < 4; ++j) { r0[j] = tab[(g0 >> 8) * 4 + j]; r1[j] = tab[(g1 >> 8) * 4 + j]; }
#pragma unroll
        for (int j = 0; j < 4; ++j) { v[j] = bf4(xv[j]); if (r1[j] < 0) v[j] = v[j] + bf4(yv[j]); }
        if ((r0[0] & r0[1] & r0[2] & r0[3] & r1[0] & r1[1] & r1[2] & r1[3]) >= 0) {
            const float ga = rowgate[g0] * (1.0f / (A8_SCALE * W8_SCALE)), gb = rowgate[g1] * (1.0f / (A8_SCALE * W8_SCALE));
#pragma unroll
            for (int j = 0; j < 4; ++j) {
                if (r0[j] >= 0) { const float* sp = slab + (size_t)(r0[j] * MOE_KSPLIT) * 65536 + (size_t)(g0 & 255) * 256 + 4 * F.lane; f32x4 a = *(const GAS f32x4*)sp;
#pragma unroll
                    for (int q = 1; q < MOE_KSPLIT; ++q) a = a + *(const GAS f32x4*)(sp + (size_t)q * 65536);
                    v[j] = v[j] + ga * a; }
                if (r1[j] >= 0) { const float* sp = slab + (size_t)(r1[j] * MOE_KSPLIT) * 65536 + (size_t)(g1 & 255) * 256 + 4 * F.lane; f32x4 a = *(const GAS f32x4*)sp;
#pragma unroll
                    for (int q = 1; q < MOE_KSPLIT; ++q) a = a + *(const GAS f32x4*)(sp + (size_t)q * 65536);
                    v[j] = v[j] + gb * a; } } }
#pragma unroll
        for (int j = 0; j < 4; ++j) s += (v[j].x * v[j].x + v[j].y * v[j].y) + (v[j].z * v[j].z + v[j].w * v[j].w);
        const float rstd = 1.f / sqrtf(wave_sum(s) * (1.f / D) + 1e-6f);
#pragma unroll
        for (int j = 0; j < 4; ++j) xr[64 * j] = v[j] * rstd * gn[j];
    }
}
__device__ __forceinline__ void moe_phases(const Frame& F, const XcdBarrier& bar, int lo, int hi) {
        DO(17, {
            const int* tiletab = (const int*)WSP(WS_MISC + MS_TILETAB);
            pg8::Gemm g{(const bf16*)WSP(WS_H), (const bf16*)WSP(WS_WGU1), D, (size_t)2 * FF * D, (const int*)WSP(WS_MISC + MS_ROWTOK), D};
            pg8::StaticOrder S; moe_order(S, tiletab, 2 * FF / 256, F.G, (int)blockIdx.x, 1, 0); moe_tiles_to_lds(F, S, tiletab);
            pg8::EpiSwiGLU8 E{WSP(WS_BIG), FF, MOE_GU_I8 ? 1.0f / (AI8_SCALE * WI8_SCALE) : 1.0f / (A8_SCALE * W8_SCALE), A8_SCALE};
            pg8::gemm_phase<pg8::EpiSwiGLU8, pg8::StaticOrder, true, false, MOE_GU_I8 ? 3 : MOE_FP8>(F.lds + RING_OFF, g, S, E, F.wave);
        });
        SEAM(17);
        DO(18, {
            const int* tiletab = (const int*)WSP(WS_MISC + MS_TILETAB);
            pg8::Gemm g{(const bf16*)WSP(WS_BIG), (const bf16*)WSP(WS_WDN1), FF, (size_t)D * FF, nullptr, FF};
            pg8::StaticOrder S; moe_order(S, tiletab, D / 256, F.G, (int)blockIdx.x, MOE_KSPLIT, 1); moe_tiles_to_lds(F, S, tiletab);
            pg8::EpiScatter E{(bf16*)arg_out(), (bf16*)WSP(WS_Y), XLD, D, (const int*)WSP(WS_MISC + MS_ROWTOK), (const float*)WSP(WS_MISC + MS_ROWGATE), 1.0f / (A8_SCALE * W8_SCALE), (float*)WSP(WS_MISC + MS_DUMMY), MOE_TILES};
            pg8::gemm_phase<pg8::EpiScatter, pg8::StaticOrder, false, false, MOE_FP8>(F.lds + RING_OFF, g, S, E, F.wave);
            S.part = 2; g.klen = FF / MOE_KSPLIT;
            pg8::EpiSlab E2{(float*)WSP(WS_SLAB2)};
            pg8::gemm_phase<pg8::EpiSlab, pg8::StaticOrder, false, true, MOE_FP8>(F.lds + RING_OFF, g, S, E2, F.wave);
        });
        SEAM(18);
    }
__global__ void __launch_bounds__(NWAVES * 64, 2) fwd(Args args) {
    extern __shared__ __attribute__((aligned(16))) unsigned char lds_raw[];
    Frame F;
    F.lds = (LAS unsigned char*)lds_raw;
    volatile LAS unsigned* MISC = (volatile LAS unsigned*)(F.lds + MISC_OFF);
    F.tid = threadIdx.x; F.lane = F.tid & 63; F.wave = __builtin_amdgcn_readfirstlane(F.tid >> 6);
    F.G = gridDim.x; { const int bx = blockIdx.x; F.vcu = (F.G % 8 == 0) ? (bx % 8) * (F.G / 8) + bx / 8 : bx; }
    { unsigned char* ws0 = arg_ws();
      for (int u = F.tid; u < (LDS_BYTES - LDSCTL_OFF) / 4; u += NWAVES * 64) ((LAS unsigned*)(F.lds + LDSCTL_OFF))[u] = 0u;
      __syncthreads();
      (void)ws0; }
    XcdBarrier bar; bar.bar = (unsigned*)(arg_ws() + WS_CTL) + CW_BAR; bar.x = 0; bar.st = nullptr;
    if (args.use_bar) bar = xcd_barrier_post((unsigned*)(arg_ws() + WS_CTL) + CW_BAR, MISC + 8);
    const int lo = args.ph_lo, hi = args.ph_hi;

    DO(0, prologue_phase(F, WSP(0)); if (WIN_I8) norm8_phase(F, arg_in(0), arg_in(1), WSP(WS_H), true); else norm_phase(F, arg_in(0), arg_in(1), (bf16*)WSP(WS_H)););
    SEAM(0);
    layer_phases<0>(F, bar, lo, hi);
    layer_phases<1>(F, bar, lo, hi);
    DO(15, router_phase(F, (const bf16*)arg_out(), arg_in(15), arg_in(16), (bf16*)WSP(WS_H), (v4u*)WSP(WS_MISC + MS_SEL), (int*)WSP(WS_MISC + MS_COUNTS)););
    SEAM(15);
    DO(16, lists_phase(F, (const v4u*)WSP(WS_MISC + MS_SEL), (const int*)WSP(WS_MISC + MS_COUNTS), (int*)WSP(WS_MISC + MS_ROWTOK), (float*)WSP(WS_MISC + MS_ROWGATE), (int*)WSP(WS_MISC + MS_TILETAB), (int*)WSP(WS_MISC + MS_TOKPOS)););
    SEAM(16);
    moe_phases(F, bar, lo, hi);
    if (RUN(20)) final_combine_norm(F);
#undef WSP
#undef RUN
#undef SEAM
}

extern "C" void kernel_launch(void* const* d_in, const int* in_sizes, int n_in, void* d_out, int out_size, void* d_ws, size_t ws_size, hipStream_t stream) {
    static int grid = 0;
    if (grid == 0) {
        if (n_in != 21 || in_sizes[0] != T * D || out_size != T * D || ws_size < WS_END) {
            fprintf(stderr, "kernel_launch: built for 21 inputs, x/out of %d floats, >= %zu bytes of workspace; got n_in %d, in0 %d, out %d, ws %zu; nothing launched\n", T * D, (size_t)WS_END, n_in, n_in > 0 ? in_sizes[0] : -1, out_size, ws_size);
            grid = -1; return; }
        int dev = 0, cus = 0, per_cu = 0;
        if (hipGetDevice(&dev) != hipSuccess || hipDeviceGetAttribute(&cus, hipDeviceAttributeMultiprocessorCount, dev) != hipSuccess) { fprintf(stderr, "kernel_launch: device query failed\n"); grid = -1; return; }
        if (hipFuncSetAttribute((const void*)fwd, hipFuncAttributeMaxDynamicSharedMemorySize, LDS_BYTES) != hipSuccess) { fprintf(stderr, "kernel_launch: hipFuncSetAttribute failed\n"); grid = -1; return; }
        if (hipOccupancyMaxActiveBlocksPerMultiprocessor(&per_cu, (const void*)fwd, NWAVES * 64, LDS_BYTES) != hipSuccess || per_cu < 1) { fprintf(stderr, "kernel_launch: occupancy query reports %d workgroups per CU\n", per_cu); }
        (void)hipGetLastError();
        if (cus != 256) { fprintf(stderr, "kernel_launch: built for 256 CUs, device has %d; nothing launched\n", cus); grid = -1; return; }
        grid = cus;
    }
    if (grid < 0) return;
    if (hipMemsetAsync((char*)d_ws + WS_CTL, 0, CTL_ZERO_BYTES, stream) != hipSuccess) { fprintf(stderr, "kernel_launch: hipMemsetAsync failed\n"); return; }
    Args a{};
    for (int i = 0; i < 21; ++i) a.in[i] = (const float*)d_in[i];
    a.out = (float*)d_out; a.ws = (unsigned char*)d_ws; a.pad = 0;
#if MK_PER_PHASE
    for (int p = 0; p < N_PHASES; ++p) { a.ph_lo = p; a.ph_hi = p + 1; a.use_bar = 0; hipLaunchKernelGGL(fwd, dim3(grid), dim3(NWAVES * 64), LDS_BYTES, stream, a); }
#else
    a.ph_lo = 0; a.ph_hi = N_PHASES; a.use_bar = 1;
    hipLaunchKernelGGL(fwd, dim3(grid), dim3(NWAVES * 64), LDS_BYTES, stream, a);
#endif
    const hipError_t le = hipPeekAtLastError();
    if (le != hipSuccess) fprintf(stderr, "kernel_launch: launch failed: %s\n", hipGetErrorName(le));
}
```
